# Optimizing an MI355X kernel written in HIP

```python
import math
import jax, jax.numpy as jnp
from jax import lax
import numpy as np

D_MODEL = 1024
BATCH = 4
SEQ = 4096
DEPTH = 4

DA_HEADS = 4
DA_HEAD_DIM = 64
DA_Q_BLOCK = 128
SW_HEADS = 8
SW_KV_HEADS = 2
SW_HEAD_DIM = 64
SW_WINDOW = 128
D_FF = 2816
CONV_WIDTH = 3
EPS = 1e-6
NEG_INF = -1e30
N_BRANCHES = 2

DA_QK_WIDTH = DA_HEADS * 2 * DA_HEAD_DIM
DA_V_WIDTH = DA_HEADS * 2 * DA_HEAD_DIM
SW_Q_WIDTH = SW_HEADS * SW_HEAD_DIM
SW_KV_WIDTH = SW_KV_HEADS * SW_HEAD_DIM
IN_SPLITS = (DA_QK_WIDTH, DA_QK_WIDTH, DA_V_WIDTH, SW_Q_WIDTH, SW_KV_WIDTH, SW_KV_WIDTH, D_MODEL, D_MODEL)
IN_COLS = 3 * DA_QK_WIDTH + SW_Q_WIDTH + 2 * SW_KV_WIDTH + N_BRANCHES * D_MODEL

kernel_name = "hybrid_diffattn_swa_sinks_convffn"


def rmsnorm(x, w):
    xf = x.astype(jnp.float32)
    y = xf * lax.rsqrt(jnp.mean(xf * xf, axis=-1, keepdims=True) + EPS)
    return (y * w.astype(jnp.float32)).astype(x.dtype)


def alibi_slopes(n_heads):
    h = jnp.arange(1, n_heads + 1, dtype=jnp.float32)
    return jnp.exp2(-8.0 * h / n_heads)


def split_cols(proj):
    idx = []
    acc = 0
    for w in IN_SPLITS[:-1]:
        acc += w
        idx.append(acc)
    return jnp.split(proj, idx, axis=-1)


def diff_attention(q, k, v, lam, lam_init, subln_w):
    B, S, _ = q.shape
    H, d = DA_HEADS, DA_HEAD_DIM
    nb = S // DA_Q_BLOCK
    q = q.reshape(B, S, H, 2, d)
    k = k.reshape(B, S, H, 2, d)
    v = v.reshape(B, S, H, 2 * d)
    slopes = alibi_slopes(H)
    qb = jnp.moveaxis(q.reshape(B, nb, DA_Q_BLOCK, H, 2, d), 1, 0)
    key_pos = jnp.arange(S)
    scale = d ** -0.5

    def block(args):
        q_blk, i = args
        s = jnp.einsum('bqhcd,bshcd->bhcqs', q_blk, k, preferred_element_type=jnp.float32) * scale
        q_pos = i * DA_Q_BLOCK + jnp.arange(DA_Q_BLOCK)
        dist = q_pos[:, None] - key_pos[None, :]
        logits = s - slopes[:, None, None, None] * dist.astype(jnp.float32)
        logits = jnp.where(dist >= 0, logits, NEG_INF)
        p = jax.nn.softmax(logits, axis=-1)
        a = p[:, :, 0] - lam * p[:, :, 1]
        return jnp.einsum('bhqs,bshe->bqhe', a.astype(v.dtype), v)

    o = lax.map(block, (qb, jnp.arange(nb)))
    o = jnp.moveaxis(o, 0, 1).reshape(B, S, H, 2 * d)
    o = rmsnorm(o, subln_w) * (1.0 - lam_init)
    return o.reshape(B, S, H * 2 * d)


def sliding_window_attention(q, k, v, sinks):
    B, S, _ = q.shape
    W, KVH, d = SW_WINDOW, SW_KV_HEADS, SW_HEAD_DIM
    G = SW_HEADS // KVH
    nb = S // W
    qb = q.reshape(B, nb, W, KVH, G, d)

    def windows(t):
        tb = t.reshape(B, nb, W, KVH, d)
        tpad = jnp.concatenate([jnp.zeros_like(tb[:, :1]), tb], axis=1)
        return jnp.concatenate([tpad[:, :-1], tpad[:, 1:]], axis=2)

    kw, vw = windows(k), windows(v)
    s = jnp.einsum('bnqkgd,bnskd->bnkgqs', qb, kw, preferred_element_type=jnp.float32) * (d ** -0.5)
    q_loc = jnp.arange(W) + W
    k_loc = jnp.arange(2 * W)
    dist = q_loc[:, None] - k_loc[None, :]
    key_abs = jnp.arange(nb)[:, None] * W + k_loc[None, :] - W
    valid = ((dist >= 0) & (dist < W))[None, :, :] & (key_abs >= 0)[:, None, :]
    slopes = alibi_slopes(SW_HEADS).reshape(KVH, G)
    logits = s - slopes[:, :, None, None] * dist.astype(jnp.float32)
    logits = jnp.where(valid[None, :, None, None], logits, NEG_INF)
    sink = jnp.broadcast_to(sinks.astype(jnp.float32).reshape(KVH, G, 1, 1), logits.shape[:-1] + (1,))
    p = jax.nn.softmax(jnp.concatenate([logits, sink], axis=-1), axis=-1)[..., :-1]
    o = jnp.einsum('bnkgqs,bnskd->bnqkgd', p.astype(v.dtype), vw)
    return o.reshape(B, S, KVH * G * d)


def conv_ffn(xn, w_up, conv_w, conv_b, w_down):
    S = xn.shape[1]
    u = xn @ w_up
    upad = jnp.pad(u, ((0, 0), (CONV_WIDTH - 1, 0), (0, 0)))
    c = conv_b
    for j in range(CONV_WIDTH):
        c = c + upad[:, j:j + S] * conv_w[j]
    gate, val = jnp.split(c, 2, axis=-1)
    return (jax.nn.silu(gate) * val) @ w_down


def setup_inputs(seed: int = 0) -> dict:
    key = jax.random.key(seed)
    ks = jax.random.split(key, 18)
    f32 = jnp.float32
    nrm = lambda k, shape, s: jax.random.normal(k, shape, f32) * s
    return {
        "x": nrm(ks[0], (BATCH, SEQ, D_MODEL), 1.0),
        "norm_mix_w": 1.0 + nrm(ks[1], (DEPTH, D_MODEL), 0.02),
        "w_in": nrm(ks[2], (DEPTH, D_MODEL, IN_COLS), D_MODEL ** -0.5),
        "lambda_q1": nrm(ks[3], (DEPTH, DA_HEAD_DIM), 0.1),
        "lambda_k1": nrm(ks[4], (DEPTH, DA_HEAD_DIM), 0.1),
        "lambda_q2": nrm(ks[5], (DEPTH, DA_HEAD_DIM), 0.1),
        "lambda_k2": nrm(ks[6], (DEPTH, DA_HEAD_DIM), 0.1),
        "subln_w": 1.0 + nrm(ks[7], (DEPTH, 2 * DA_HEAD_DIM), 0.02),
        "sinks": nrm(ks[8], (DEPTH, SW_HEADS), 0.5),
        "w_br_da": nrm(ks[9], (DEPTH, DA_V_WIDTH, D_MODEL), DA_V_WIDTH ** -0.5),
        "w_br_sw": nrm(ks[10], (DEPTH, SW_Q_WIDTH, D_MODEL), SW_Q_WIDTH ** -0.5),
        "w_mix_out": nrm(ks[11], (DEPTH, D_MODEL, D_MODEL), D_MODEL ** -0.5),
        "norm_ffn_w": 1.0 + nrm(ks[12], (DEPTH, D_MODEL), 0.02),
        "w_up": nrm(ks[13], (DEPTH, D_MODEL, 2 * D_FF), D_MODEL ** -0.5),
        "conv_w": nrm(ks[14], (DEPTH, CONV_WIDTH, 2 * D_FF), CONV_WIDTH ** -0.5),
        "conv_b": nrm(ks[15], (DEPTH, 2 * D_FF), 0.02),
        "w_down": nrm(ks[16], (DEPTH, D_FF, D_MODEL), D_FF ** -0.5),
        "norm_final_w": 1.0 + nrm(ks[17], (D_MODEL,), 0.02),
    }


def reference(x, norm_mix_w, w_in, lambda_q1, lambda_k1, lambda_q2, lambda_k2, subln_w, sinks,
              w_br_da, w_br_sw, w_mix_out, norm_ffn_w, w_up, conv_w, conv_b, w_down, norm_final_w):
    for l in range(DEPTH):
        lam_init = 0.8 - 0.6 * math.exp(-0.3 * l)
        xn = rmsnorm(x, norm_mix_w[l])
        proj = xn @ w_in[l]
        da_q, da_k, da_v, sw_q, sw_k, sw_v, g_da, g_sw = split_cols(proj)
        lam = (jnp.exp(jnp.sum(lambda_q1[l].astype(jnp.float32) * lambda_k1[l].astype(jnp.float32)))
               - jnp.exp(jnp.sum(lambda_q2[l].astype(jnp.float32) * lambda_k2[l].astype(jnp.float32)))
               + lam_init)
        y_da = diff_attention(da_q, da_k, da_v, lam, lam_init, subln_w[l])
        y_sw = sliding_window_attention(sw_q, sw_k, sw_v, sinks[l])
        merged = jax.nn.sigmoid(g_da) * (y_da @ w_br_da[l]) + jax.nn.sigmoid(g_sw) * (y_sw @ w_br_sw[l])
        x = x + merged @ w_mix_out[l]
        xn = rmsnorm(x, norm_ffn_w[l])
        x = x + conv_ffn(xn, w_up[l], conv_w[l], conv_b[l], w_down[l])
    return rmsnorm(x, norm_final_w)
```

```cpp
#include <hip/hip_runtime.h>
#include <hip/hip_cooperative_groups.h>
#include <cstdio>
namespace cg = cooperative_groups;

typedef unsigned short bf16_t;
typedef short bf16x8 __attribute__((ext_vector_type(8)));
typedef float f32x16 __attribute__((ext_vector_type(16)));
typedef float f32x4 __attribute__((ext_vector_type(4)));
typedef unsigned u32x4 __attribute__((ext_vector_type(4)));
typedef unsigned u32x2 __attribute__((ext_vector_type(2)));

#define DEVI __device__ __forceinline__

constexpr int DM = 1024, NTOK = 16384, SEQ = 4096, DEPTH = 4;
constexpr int INC = 4352, DFF = 2816, DFF2 = 5632;
constexpr float EPS = 1e-6f;
constexpr float LOG2E = 1.4426950408889634f;
constexpr float QSCALE = 0.125f * LOG2E;

constexpr size_t SZ_WT_IN = (size_t)INC * DM * 2, SZ_WT_BR = (size_t)DM * 512 * 2, SZ_WT_MIX = (size_t)DM * DM * 2,
                 SZ_WT_UP = (size_t)DFF2 * DM * 2, SZ_WT_DN = (size_t)DM * DFF * 2;
constexpr size_t OFF_WT_IN = 0;
constexpr size_t OFF_WT_DA = OFF_WT_IN + DEPTH * SZ_WT_IN;
constexpr size_t OFF_WT_SW = OFF_WT_DA + DEPTH * SZ_WT_BR;
constexpr size_t OFF_WT_MIX = OFF_WT_SW + DEPTH * SZ_WT_BR;
constexpr size_t OFF_WT_UP = OFF_WT_MIX + DEPTH * SZ_WT_MIX;
constexpr size_t OFF_WT_DN = OFF_WT_UP + DEPTH * SZ_WT_UP;
constexpr size_t OFF_XB = OFF_WT_DN + DEPTH * SZ_WT_DN;
constexpr size_t OFF_SSQ_MIX = OFF_XB + (size_t)NTOK * DM * 2;
constexpr size_t OFF_SSQ_FFN = OFF_SSQ_MIX + (size_t)NTOK * 16 * 4;
constexpr size_t OFF_CTR = OFF_SSQ_FFN + (size_t)NTOK * 16 * 4;
constexpr size_t OFF_QKDA = OFF_CTR + 256;
constexpr size_t OFF_VTDA = OFF_QKDA + (size_t)NTOK * 1024 * 2;
constexpr size_t OFF_QSW = OFF_VTDA + (size_t)NTOK * 512 * 2;
constexpr size_t OFF_KSW = OFF_QSW + (size_t)NTOK * 512 * 2;
constexpr size_t OFF_VTSW = OFF_KSW + (size_t)NTOK * 128 * 2;
constexpr size_t OFF_GATES = OFF_VTSW + (size_t)NTOK * 128 * 2;
constexpr size_t OFF_Y = OFF_GATES + (size_t)NTOK * 2048 * 2;
constexpr size_t WS_TOTAL = OFF_Y + (size_t)NTOK * 1024 * 2;

struct Params {
    const float *x, *norm_mix_w, *w_in, *lq1, *lk1, *lq2, *lk2, *subln_w, *sinks, *w_br_da, *w_br_sw, *w_mix_out,
        *norm_ffn_w, *w_up, *conv_w, *conv_b, *w_down, *norm_final_w;
    float* out;
    char* ws;
};

constexpr int SMEM_BYTES = 73728;

typedef __bf16 bf16v2 __attribute__((ext_vector_type(2)));
typedef float f32x2 __attribute__((ext_vector_type(2)));
DEVI unsigned pk_bf16(float lo, float hi) {
    bf16v2 r = __builtin_convertvector((f32x2){lo, hi}, bf16v2);
    return __builtin_bit_cast(unsigned, r);
}
DEVI float bf2f_lo(unsigned u) { return __uint_as_float(u << 16); }
DEVI float bf2f_hi(unsigned u) { return __uint_as_float(u & 0xffff0000u); }
DEVI float fast_sigmoid(float x) { return __builtin_amdgcn_rcpf(1.0f + __builtin_amdgcn_exp2f(-x * LOG2E)); }
DEVI float shfl_xor32(float v) { return __shfl_xor(v, 32, 64); }
DEVI float row_ssq(const float* __restrict__ ssq, int tok) {
    const f32x4 a = *(const f32x4*)(ssq + (size_t)tok * 16), b = *(const f32x4*)(ssq + (size_t)tok * 16 + 4),
                c = *(const f32x4*)(ssq + (size_t)tok * 16 + 8), d = *(const f32x4*)(ssq + (size_t)tok * 16 + 12);
    return ((a[0] + a[1]) + (a[2] + a[3])) + ((b[0] + b[1]) + (b[2] + b[3])) + ((c[0] + c[1]) + (c[2] + c[3])) + ((d[0] + d[1]) + (d[2] + d[3]));
}
DEVI int opaque_tid() { int t = threadIdx.x; asm volatile("" : "+v"(t)); return t; }

__device__ void phase_convert(const Params& p, char* smem) {
    float* T = (float*)smem;
    const int tid = opaque_tid();
    if (blockIdx.x == 0 && tid < 64) ((int*)(p.ws + OFF_CTR))[tid] = 0;
    for (int t = blockIdx.x; t < DEPTH * 3712; t += gridDim.x) {
        const int l = t / 3712;
        int r = t % 3712;
        const float* W;
        const float* sc = nullptr;
        bf16_t* D;
        int K, N, mode = 0, scmask = 0x7fffffff;
        float scmul = 1.0f;
        if (r < 1088) {
            W = p.w_in + (size_t)l * DM * INC; K = DM; N = INC; sc = p.norm_mix_w + l * DM;
            D = (bf16_t*)(p.ws + OFF_WT_IN + l * SZ_WT_IN);
        } else if ((r -= 1088) < 128) {
            W = p.w_br_da + (size_t)l * 512 * DM; K = 512; N = DM; D = (bf16_t*)(p.ws + OFF_WT_DA + l * SZ_WT_BR);
            sc = p.subln_w + l * 128; scmask = 127; scmul = 1.0f - (0.8f - 0.6f * expf(-0.3f * (float)l));
        } else if ((r -= 128) < 128) {
            W = p.w_br_sw + (size_t)l * 512 * DM; K = 512; N = DM; D = (bf16_t*)(p.ws + OFF_WT_SW + l * SZ_WT_BR);
        } else if ((r -= 128) < 256) {
            W = p.w_mix_out + (size_t)l * DM * DM; K = DM; N = DM; D = (bf16_t*)(p.ws + OFF_WT_MIX + l * SZ_WT_MIX);
        } else if ((r -= 256) < 1408) {
            W = p.w_up + (size_t)l * DM * DFF2; K = DM; N = DFF2; sc = p.norm_ffn_w + l * DM; mode = 1;
            D = (bf16_t*)(p.ws + OFF_WT_UP + l * SZ_WT_UP);
        } else {
            r -= 1408;
            W = p.w_down + (size_t)l * DFF * DM; K = DFF; N = DM; D = (bf16_t*)(p.ws + OFF_WT_DN + l * SZ_WT_DN);
        }
        const int ntn = N >> 6;
        const int k0 = (r / ntn) * 64, n0 = (r % ntn) * 64;
        __syncthreads();
#pragma unroll
        for (int i = 0; i < 4; ++i) {
            const int kr = (tid >> 4) + 16 * i, c4 = (tid & 15) * 4;
            f32x4 v = *(const f32x4*)(W + (size_t)(k0 + kr) * N + n0 + c4);
            const float s = sc ? sc[(k0 + kr) & scmask] * scmul : 1.0f;
            T[kr * 65 + c4 + 0] = v[0] * s; T[kr * 65 + c4 + 1] = v[1] * s;
            T[kr * 65 + c4 + 2] = v[2] * s; T[kr * 65 + c4 + 3] = v[3] * s;
        }
        __syncthreads();
        {
            const int nl = tid >> 2, kc = (tid & 3) * 16;
            int n = n0 + nl;
            if (mode == 1) n = (n < DFF) ? ((n >> 6) * 128 + (n & 63)) : (((n - DFF) >> 6) * 128 + 64 + ((n - DFF) & 63));
            unsigned o[8];
#pragma unroll
            for (int e = 0; e < 8; ++e) o[e] = pk_bf16(T[(kc + 2 * e) * 65 + nl], T[(kc + 2 * e + 1) * 65 + nl]);
            bf16_t* dst = D + (size_t)n * K + k0 + kc;
            *(u32x4*)dst = (u32x4){o[0], o[1], o[2], o[3]};
            *(u32x4*)(dst + 8) = (u32x4){o[4], o[5], o[6], o[7]};
        }
    }
    {
        const int lane = tid & 63, wave = tid >> 6;
        bf16_t* XB = (bf16_t*)(p.ws + OFF_XB);
        float* ssq = (float*)(p.ws + OFF_SSQ_MIX);
        for (int row = blockIdx.x * 4 + wave; row < NTOK; row += gridDim.x * 4) {
            const float* xr = p.x + (size_t)row * DM;
            float s = 0.f;
#pragma unroll
            for (int i = 0; i < 4; ++i) {
                f32x4 v = *(const f32x4*)(xr + i * 256 + lane * 4);
                s += v[0] * v[0] + v[1] * v[1] + v[2] * v[2] + v[3] * v[3];
                *(u32x2*)(XB + (size_t)row * DM + i * 256 + lane * 4) = (u32x2){pk_bf16(v[0], v[1]), pk_bf16(v[2], v[3])};
            }
#pragma unroll
            for (int o = 32; o >= 1; o >>= 1) s += __shfl_xor(s, o, 64);
            if (lane < 16) ssq[(size_t)row * 16 + lane] = (lane == 0) ? s : 0.f;
        }
    }
}

constexpr int TROWB = 144;
constexpr int TBUF = 128 * TROWB;
template <bool SWAP>
DEVI void gemm_mainloop(f32x16 (&acc)[2][2], const bf16_t* __restrict__ A, const int (&aoff)[4], const bf16_t* __restrict__ B,
                        const int (&boff)[4], int nk, char* smem) {
    const int tid = opaque_tid(), lane = tid & 63, wave = tid >> 6;
    const int wm = wave >> 1, wn = wave & 1;
    const int g = lane >> 5, q = lane & 31;
    const int st_off = (tid >> 3) * TROWB + (tid & 7) * 16;
    const int a_rd = (wm * 64 + q) * TROWB + g * 16;
    const int b_rd = (wn * 64 + q) * TROWB + g * 16;
    u32x4 ra[4], rb[4];
#pragma unroll
    for (int i = 0; i < 4; ++i) { ra[i] = *(const u32x4*)(A + aoff[i]); rb[i] = *(const u32x4*)(B + boff[i]); }
    __syncthreads();
#pragma unroll
    for (int i = 0; i < 4; ++i) {
        *(u32x4*)(smem + st_off + i * 32 * TROWB) = ra[i];
        *(u32x4*)(smem + 2 * TBUF + st_off + i * 32 * TROWB) = rb[i];
    }
    __syncthreads();
    for (int kt = 0; kt < nk; ++kt) {
        const int cur = kt & 1;
        const bool more = (kt + 1 < nk);
        if (more) {
#pragma unroll
            for (int i = 0; i < 4; ++i) {
                ra[i] = *(const u32x4*)(A + aoff[i] + (kt + 1) * 64);
                rb[i] = *(const u32x4*)(B + boff[i] + (kt + 1) * 64);
            }
        }
        const char* As = smem + cur * TBUF;
        const char* Bs = smem + 2 * TBUF + cur * TBUF;
#pragma unroll
        for (int kk = 0; kk < 4; ++kk) {
            bf16x8 af[2], bf[2];
#pragma unroll
            for (int mi = 0; mi < 2; ++mi) af[mi] = *(const bf16x8*)(As + a_rd + mi * 32 * TROWB + kk * 32);
#pragma unroll
            for (int ni = 0; ni < 2; ++ni) bf[ni] = *(const bf16x8*)(Bs + b_rd + ni * 32 * TROWB + kk * 32);
#pragma unroll
            for (int mi = 0; mi < 2; ++mi)
#pragma unroll
                for (int ni = 0; ni < 2; ++ni) {
                    if (SWAP) acc[mi][ni] = __builtin_amdgcn_mfma_f32_32x32x16_bf16(af[mi], bf[ni], acc[mi][ni], 0, 0, 0);
                    else acc[mi][ni] = __builtin_amdgcn_mfma_f32_32x32x16_bf16(bf[ni], af[mi], acc[mi][ni], 0, 0, 0);
                }
        }
        if (more) {
            char* Ad = smem + (cur ^ 1) * TBUF;
            char* Bd = smem + 2 * TBUF + (cur ^ 1) * TBUF;
#pragma unroll
            for (int i = 0; i < 4; ++i) {
                *(u32x4*)(Ad + st_off + i * 32 * TROWB) = ra[i];
                *(u32x4*)(Bd + st_off + i * 32 * TROWB) = rb[i];
            }
        }
        __syncthreads();
    }
}

DEVI void zero_acc(f32x16 (&acc)[2][2]) {
#pragma unroll
    for (int mi = 0; mi < 2; ++mi)
#pragma unroll
        for (int ni = 0; ni < 2; ++ni)
#pragma unroll
            for (int r = 0; r < 16; ++r) acc[mi][ni][r] = 0.f;
}

DEVI void tile_order(int t, int MT, int NT, int& mt, int& nt) {
    const int grp = t / (8 * NT);
    const int first = grp * 8;
    const int gsz = (MT - first) < 8 ? (MT - first) : 8;
    const int rem = t - grp * 8 * NT;
    mt = first + rem % gsz;
    nt = rem / gsz;
}

__device__ void phase_inproj(const Params& p, int l, char* smem) {
    const int tid = opaque_tid(), lane = tid & 63, wave = tid >> 6, wm = wave >> 1, wn = wave & 1, g = lane >> 5, q = lane & 31;
    const bf16_t* XB = (const bf16_t*)(p.ws + OFF_XB);
    const bf16_t* WT = (const bf16_t*)(p.ws + OFF_WT_IN + l * SZ_WT_IN);
    const float* ssq = (const float*)(p.ws + OFF_SSQ_MIX);
    for (int t = blockIdx.x; t < 128 * 34; t += gridDim.x) {
        int mt, nt;
        tile_order(t, 128, 34, mt, nt);
        const int m0 = mt * 128, n0 = nt * 128;
        int aoff[4], boff[4];
#pragma unroll
        for (int i = 0; i < 4; ++i) {
            const int row = (tid >> 3) + 32 * i, ch = tid & 7;
            aoff[i] = (m0 + row) * DM + ch * 8;
            boff[i] = (n0 + row) * DM + ch * 8;
        }
        f32x16 acc[2][2];
        zero_acc(acc);
        const bool isv = (nt >= 8 && nt < 12) || nt == 17;
        if (!isv) {
            gemm_mainloop<false>(acc, XB, aoff, WT, boff, DM / 64, smem);
            bf16_t* dst; int ld, coff; int mode;
            if (nt < 4) { dst = (bf16_t*)(p.ws + OFF_QKDA); ld = 1024; coff = n0; mode = 0; }
            else if (nt < 8) { dst = (bf16_t*)(p.ws + OFF_QKDA); ld = 1024; coff = n0; mode = 1; }
            else if (nt < 16) { dst = (bf16_t*)(p.ws + OFF_QSW); ld = 512; coff = n0 - 1536; mode = 0; }
            else if (nt == 16) { dst = (bf16_t*)(p.ws + OFF_KSW); ld = 128; coff = 0; mode = 1; }
            else { dst = (bf16_t*)(p.ws + OFF_GATES); ld = 2048; coff = n0 - 2304; mode = 2; }
#pragma unroll
            for (int mi = 0; mi < 2; ++mi) {
                const int tok = m0 + wm * 64 + 32 * mi + q;
                float rs = __builtin_amdgcn_rsqf(row_ssq(ssq, tok) * (1.0f / DM) + EPS);
                if (mode == 0) rs *= QSCALE;
#pragma unroll
                for (int ni = 0; ni < 2; ++ni)
#pragma unroll
                    for (int j = 0; j < 4; ++j) {
                        float v0 = acc[mi][ni][4 * j + 0] * rs, v1 = acc[mi][ni][4 * j + 1] * rs, v2 = acc[mi][ni][4 * j + 2] * rs,
                              v3 = acc[mi][ni][4 * j + 3] * rs;
                        if (mode == 2) { v0 = fast_sigmoid(v0); v1 = fast_sigmoid(v1); v2 = fast_sigmoid(v2); v3 = fast_sigmoid(v3); }
                        const int nl = wn * 64 + 32 * ni + 8 * j + 4 * g;
                        *(u32x2*)(dst + (size_t)tok * ld + coff + nl) = (u32x2){pk_bf16(v0, v1), pk_bf16(v2, v3)};
                    }
            }
        } else {
            gemm_mainloop<true>(acc, XB, aoff, WT, boff, DM / 64, smem);
            bf16_t* dst; int rowbase;
            const int b = m0 >> 12, s0 = m0 & 4095;
            int rows_per_b;
            if (nt < 12) { dst = (bf16_t*)(p.ws + OFF_VTDA); rowbase = (nt - 8) * 128; rows_per_b = 512; }
            else { dst = (bf16_t*)(p.ws + OFF_VTSW); rowbase = 0; rows_per_b = 128; }
#pragma unroll
            for (int mi = 0; mi < 2; ++mi)
#pragma unroll
                for (int j = 0; j < 4; ++j) {
                    const int sl = wm * 64 + 32 * mi + 8 * j + 4 * g;
                    f32x4 sq;
                    sq[0] = row_ssq(ssq, m0 + sl); sq[1] = row_ssq(ssq, m0 + sl + 1); sq[2] = row_ssq(ssq, m0 + sl + 2); sq[3] = row_ssq(ssq, m0 + sl + 3);
                    float r0 = __builtin_amdgcn_rsqf(sq[0] * (1.0f / DM) + EPS), r1 = __builtin_amdgcn_rsqf(sq[1] * (1.0f / DM) + EPS),
                          r2 = __builtin_amdgcn_rsqf(sq[2] * (1.0f / DM) + EPS), r3 = __builtin_amdgcn_rsqf(sq[3] * (1.0f / DM) + EPS);
#pragma unroll
                    for (int ni = 0; ni < 2; ++ni) {
                        const int nl = wn * 64 + 32 * ni + q;
                        bf16_t* d = dst + ((size_t)(b * rows_per_b + rowbase + nl)) * SEQ + s0 + sl;
                        *(u32x2*)d = (u32x2){pk_bf16(acc[mi][ni][4 * j + 0] * r0, acc[mi][ni][4 * j + 1] * r1),
                                             pk_bf16(acc[mi][ni][4 * j + 2] * r2, acc[mi][ni][4 * j + 3] * r3)};
                    }
                }
        }
    }
}

#define CJI(r) (16 * ((r) >> 3) + ((r) & 7))
template <int NMAP, int DV, bool SW>
DEVI void attn_item(const bf16_t* __restrict__ Qp, int ldq, const bf16_t* __restrict__ Kp, int ldk, const bf16_t* __restrict__ VTp,
                    bf16_t* __restrict__ Yp, int ldy, int qw, int kbeg, int kend, float slope2, float sink2, float lam,
                    const float* __restrict__ subw, float oscale, char* smem) {
    constexpr int KROWB = NMAP * 128 + 16;
    constexpr int KCH = NMAP * 8;
    constexpr int NB = DV / 32;
    char* Ks = smem;
    char* Vs = smem + 64 * KROWB;
    const int tid = opaque_tid(), lane = tid & 63, q = lane & 31, g = lane >> 5;
    const int qpos = qw + q;
    char* Qs = smem + 64 * KROWB + DV * 144 + (tid >> 6) * 32 * KROWB;
#pragma unroll
    for (int i = 0; i < (32 * KCH) / 64; ++i) {
        const int id = lane + 64 * i, row = id / KCH, ch = id % KCH;
        u32x4 v = *(const u32x4*)(Qp + (size_t)(qw + row) * ldq + ch * 8);
        *(u32x4*)(Qs + row * KROWB + ch * 16) = v;
    }
    const int qoff = q * KROWB + g * 16;
    f32x16 O[NMAP][NB];
#pragma unroll
    for (int c = 0; c < NMAP; ++c)
#pragma unroll
        for (int b = 0; b < NB; ++b)
#pragma unroll
            for (int r = 0; r < 16; ++r) O[c][b][r] = 0.f;
    float m[NMAP], lsum[NMAP];
#pragma unroll
    for (int c = 0; c < NMAP; ++c) { m[c] = SW ? sink2 : -1e30f; lsum[c] = (SW && g == 0) ? 1.f : 0.f; }
    const int pr = (q & 0x13) | ((q & 4) << 1) | ((q & 8) >> 1);
    const int koff = pr * KROWB + g * 16;
    const int voff = q * 144 + g * 16;
    for (int kt0 = kbeg; kt0 < kend; kt0 += 64) {
        if (SW && kt0 + 63 < 0) continue;
        __syncthreads();
#pragma unroll
        for (int i = 0; i < (64 * KCH) / 256; ++i) {
            const int id = tid + 256 * i, row = id / KCH, ch = id % KCH;
            int tok = kt0 + row;
            tok = tok < 0 ? 0 : (tok > SEQ - 1 ? SEQ - 1 : tok);
            u32x4 v = *(const u32x4*)(Kp + (size_t)tok * ldk + ch * 8);
            *(u32x4*)(Ks + row * KROWB + ch * 16) = v;
        }
#pragma unroll
        for (int i = 0; i < (DV * 8) / 256; ++i) {
            const int id = tid + 256 * i, r = id >> 3, ch = id & 7;
            int s = kt0 + ch * 8;
            s = s < 0 ? 0 : (s > SEQ - 8 ? SEQ - 8 : s);
            u32x4 v = *(const u32x4*)(VTp + (size_t)r * SEQ + s);
            *(u32x4*)(Vs + r * 144 + ch * 16) = v;
        }
        __syncthreads();
        if (!SW && kt0 > qw + 31) continue;
#pragma unroll 1
        for (int sub = 0; sub < 2; ++sub) {
            const int ks0 = kt0 + 32 * sub;
            if (!SW && ks0 > qw + 31) break;
            const int relbase = ks0 + 8 * g - qpos;
            const float basef = slope2 * (float)relbase;
            const bool need_mask = SW || (ks0 + 31 > qw);
            bf16x8 P[NMAP][2];
#pragma unroll
            for (int c = 0; c < NMAP; ++c) {
                f32x16 S;
#pragma unroll
                for (int r = 0; r < 16; ++r) S[r] = __builtin_fmaf(slope2, (float)CJI(r), basef);
#pragma unroll
                for (int kk = 0; kk < 4; ++kk) {
                    bf16x8 kf = *(const bf16x8*)(Ks + sub * 32 * KROWB + koff + c * 128 + kk * 32);
                    bf16x8 qfr = *(const bf16x8*)(Qs + qoff + c * 128 + kk * 32);
                    S = __builtin_amdgcn_mfma_f32_32x32x16_bf16(kf, qfr, S, 0, 0, 0);
                }
                if (need_mask) {
#pragma unroll
                    for (int r = 0; r < 16; ++r) {
                        const int rel = relbase + CJI(r);
                        bool valid = rel <= 0;
                        if (SW) valid = valid && (rel > -128) && (rel + qpos >= 0);
                        S[r] = valid ? S[r] : -1e30f;
                    }
                }
                float mx = S[0];
#pragma unroll
                for (int r = 1; r < 16; ++r) mx = fmaxf(mx, S[r]);
                mx = fmaxf(mx, shfl_xor32(mx));
                const float mn = fmaxf(m[c], mx);
                const float alpha = __builtin_amdgcn_exp2f(m[c] - mn);
                m[c] = mn;
                float ps = 0.f;
#pragma unroll
                for (int r = 0; r < 16; ++r) { S[r] = __builtin_amdgcn_exp2f(S[r] - mn); ps += S[r]; }
                lsum[c] = lsum[c] * alpha + ps;
#pragma unroll
                for (int t = 0; t < 2; ++t) {
                    u32x4 pk = (u32x4){pk_bf16(S[8 * t + 0], S[8 * t + 1]), pk_bf16(S[8 * t + 2], S[8 * t + 3]),
                                       pk_bf16(S[8 * t + 4], S[8 * t + 5]), pk_bf16(S[8 * t + 6], S[8 * t + 7])};
                    P[c][t] = __builtin_bit_cast(bf16x8, pk);
                }
#pragma unroll
                for (int b = 0; b < NB; ++b)
#pragma unroll
                    for (int r = 0; r < 16; ++r) O[c][b][r] *= alpha;
            }
#pragma unroll
            for (int t = 0; t < 2; ++t)
#pragma unroll
                for (int b = 0; b < NB; ++b) {
                    bf16x8 vf = *(const bf16x8*)(Vs + b * 32 * 144 + voff + sub * 64 + t * 32);
#pragma unroll
                    for (int c = 0; c < NMAP; ++c) O[c][b] = __builtin_amdgcn_mfma_f32_32x32x16_bf16(vf, P[c][t], O[c][b], 0, 0, 0);
                }
        }
    }
    if (!SW) {
        const float l0 = lsum[0] + shfl_xor32(lsum[0]);
        const float l1 = lsum[NMAP - 1] + shfl_xor32(lsum[NMAP - 1]);
        const float inv0 = 1.0f / l0, inv1 = lam / l1;
        float ss = 0.f;
#pragma unroll
        for (int b = 0; b < NB; ++b)
#pragma unroll
            for (int r = 0; r < 16; ++r) {
                const float a = O[0][b][r] * inv0 - O[NMAP - 1][b][r] * inv1;
                O[0][b][r] = a;
                ss += a * a;
            }
        ss += shfl_xor32(ss);
        const float rn = __builtin_amdgcn_rsqf(ss * (1.0f / DV) + EPS);
#pragma unroll
        for (int b = 0; b < NB; ++b)
#pragma unroll
            for (int j = 0; j < 4; ++j) {
                const int dv = 32 * b + 8 * j + 4 * g;
                *(u32x2*)(Yp + (size_t)qpos * ldy + dv) = (u32x2){pk_bf16(O[0][b][4 * j + 0] * rn, O[0][b][4 * j + 1] * rn),
                                                                  pk_bf16(O[0][b][4 * j + 2] * rn, O[0][b][4 * j + 3] * rn)};
            }
    } else {
        const float l0 = lsum[0] + shfl_xor32(lsum[0]);
        const float inv0 = 1.0f / l0;
#pragma unroll
        for (int b = 0; b < NB; ++b)
#pragma unroll
            for (int j = 0; j < 4; ++j) {
                const int dv = 32 * b + 8 * j + 4 * g;
                *(u32x2*)(Yp + (size_t)qpos * ldy + dv) = (u32x2){pk_bf16(O[0][b][4 * j + 0] * inv0, O[0][b][4 * j + 1] * inv0),
                                                                  pk_bf16(O[0][b][4 * j + 2] * inv0, O[0][b][4 * j + 3] * inv0)};
            }
    }
}

__device__ void phase_attn(const Params& p, int l, float lam, float lam_init, char* smem, int* s_item) {
    const int tid = opaque_tid(), wave = tid >> 6;
    int* ctr = (int*)(p.ws + OFF_CTR) + l;
    const bf16_t* QKDA = (const bf16_t*)(p.ws + OFF_QKDA);
    const bf16_t* VTDA = (const bf16_t*)(p.ws + OFF_VTDA);
    const bf16_t* QSW = (const bf16_t*)(p.ws + OFF_QSW);
    const bf16_t* KSW = (const bf16_t*)(p.ws + OFF_KSW);
    const bf16_t* VTSW = (const bf16_t*)(p.ws + OFF_VTSW);
    bf16_t* Y = (bf16_t*)(p.ws + OFF_Y);
    for (int it0 = blockIdx.x; it0 < 1536; it0 += gridDim.x) {
        int it = it0;
        __syncthreads();
        if (it < 512) {
            const int qb = 31 - (it >> 4), bh = it & 15, b = bh >> 2, h = bh & 3;
            const int q0 = qb * 128;
            const float slope2 = exp2f(-2.0f * (h + 1)) * LOG2E;
            attn_item<2, 128, false>(QKDA + (size_t)b * SEQ * 1024 + h * 128, 1024, QKDA + (size_t)b * SEQ * 1024 + 512 + h * 128, 1024,
                                     VTDA + (size_t)(b * 4 + h) * 128 * SEQ, Y + (size_t)b * SEQ * 1024 + h * 128, 1024, q0 + 32 * wave, 0,
                                     q0 + 128, slope2, 0.f, lam, p.subln_w + l * 128, 1.0f - lam_init, smem);
        } else {
            it -= 512;
            const int b = it >> 8, r = it & 255, kvh = r >> 7, qblk = r & 127;
            const int qw = qblk * 32, head = kvh * 4 + wave;
            const float slope2 = exp2f(-(float)(head + 1)) * LOG2E;
            const float sink2 = p.sinks[l * 8 + head] * LOG2E;
            attn_item<1, 64, true>(QSW + (size_t)b * SEQ * 512 + head * 64, 512, KSW + (size_t)b * SEQ * 128 + kvh * 64, 128,
                                   VTSW + (size_t)(b * 2 + kvh) * 64 * SEQ, Y + (size_t)b * SEQ * 1024 + 512 + head * 64, 1024, qw, qw - 128,
                                   qw + 64, slope2, sink2, 0.f, nullptr, 1.0f, smem);
        }
    }
}

__device__ void phase_branch(const Params& p, int l, char* smem) {
    const int tid = opaque_tid(), lane = tid & 63, wave = tid >> 6, wm = wave >> 1, wn = wave & 1, g = lane >> 5, q = lane & 31;
    const bf16_t* Y = (const bf16_t*)(p.ws + OFF_Y);
    const bf16_t* G = (const bf16_t*)(p.ws + OFF_GATES);
    bf16_t* MG = (bf16_t*)(p.ws + OFF_QKDA);
    const bf16_t* W1 = (const bf16_t*)(p.ws + OFF_WT_DA + l * SZ_WT_BR);
    const bf16_t* W2 = (const bf16_t*)(p.ws + OFF_WT_SW + l * SZ_WT_BR);
    for (int t = blockIdx.x; t < 128 * 8; t += gridDim.x) {
        int mt, nt;
        tile_order(t, 128, 8, mt, nt);
        const int m0 = mt * 128, n0 = nt * 128;
        int aoff[4], boff[4];
#pragma unroll
        for (int i = 0; i < 4; ++i) {
            const int row = (tid >> 3) + 32 * i, ch = tid & 7;
            aoff[i] = (m0 + row) * 1024 + ch * 8;
            boff[i] = (n0 + row) * 512 + ch * 8;
        }
        f32x16 acc[2][2];
        zero_acc(acc);
        gemm_mainloop<false>(acc, Y, aoff, W1, boff, 512 / 64, smem);
#pragma unroll
        for (int mi = 0; mi < 2; ++mi) {
            const int tok = m0 + wm * 64 + 32 * mi + q;
#pragma unroll
            for (int ni = 0; ni < 2; ++ni)
#pragma unroll
                for (int j = 0; j < 4; ++j) {
                    const int n = n0 + wn * 64 + 32 * ni + 8 * j + 4 * g;
                    u32x2 g1 = *(const u32x2*)(G + (size_t)tok * 2048 + n);
                    u32x2 g2 = *(const u32x2*)(G + (size_t)tok * 2048 + 1024 + n);
                    acc[mi][ni][4 * j + 0] *= bf2f_lo(g1[0]) * __builtin_amdgcn_rcpf(bf2f_lo(g2[0]));
                    acc[mi][ni][4 * j + 1] *= bf2f_hi(g1[0]) * __builtin_amdgcn_rcpf(bf2f_hi(g2[0]));
                    acc[mi][ni][4 * j + 2] *= bf2f_lo(g1[1]) * __builtin_amdgcn_rcpf(bf2f_lo(g2[1]));
                    acc[mi][ni][4 * j + 3] *= bf2f_hi(g1[1]) * __builtin_amdgcn_rcpf(bf2f_hi(g2[1]));
                }
        }
        gemm_mainloop<false>(acc, Y + 512, aoff, W2, boff, 512 / 64, smem);
#pragma unroll
        for (int mi = 0; mi < 2; ++mi) {
            const int tok = m0 + wm * 64 + 32 * mi + q;
#pragma unroll
            for (int ni = 0; ni < 2; ++ni)
#pragma unroll
                for (int j = 0; j < 4; ++j) {
                    const int n = n0 + wn * 64 + 32 * ni + 8 * j + 4 * g;
                    u32x2 gv = *(const u32x2*)(G + (size_t)tok * 2048 + 1024 + n);
                    const float v0 = acc[mi][ni][4 * j + 0] * bf2f_lo(gv[0]);
                    const float v1 = acc[mi][ni][4 * j + 1] * bf2f_hi(gv[0]);
                    const float v2 = acc[mi][ni][4 * j + 2] * bf2f_lo(gv[1]);
                    const float v3 = acc[mi][ni][4 * j + 3] * bf2f_hi(gv[1]);
                    *(u32x2*)(MG + (size_t)tok * 1024 + n) = (u32x2){pk_bf16(v0, v1), pk_bf16(v2, v3)};
                }
        }
    }
}

__device__ void phase_resid(const Params& p, const bf16_t* A, int lda, const bf16_t* WT, int K, const float* xold, float* ssq, char* smem) {
    const int tid = opaque_tid(), lane = tid & 63, wave = tid >> 6, wm = wave >> 1, wn = wave & 1, g = lane >> 5, q = lane & 31;
    bf16_t* XB = (bf16_t*)(p.ws + OFF_XB);
    for (int t = blockIdx.x; t < 128 * 8; t += gridDim.x) {
        int mt, nt;
        tile_order(t, 128, 8, mt, nt);
        const int m0 = mt * 128, n0 = nt * 128;
        int aoff[4], boff[4];
#pragma unroll
        for (int i = 0; i < 4; ++i) {
            const int row = (tid >> 3) + 32 * i, ch = tid & 7;
            aoff[i] = (m0 + row) * lda + ch * 8;
            boff[i] = (n0 + row) * K + ch * 8;
        }
        f32x16 acc[2][2];
        zero_acc(acc);
        gemm_mainloop<false>(acc, A, aoff, WT, boff, K / 64, smem);
#pragma unroll
        for (int mi = 0; mi < 2; ++mi) {
            const int tok = m0 + wm * 64 + 32 * mi + q;
            float s = 0.f;
#pragma unroll
            for (int ni = 0; ni < 2; ++ni)
#pragma unroll
                for (int j = 0; j < 4; ++j) {
                    const int n = n0 + wn * 64 + 32 * ni + 8 * j + 4 * g;
                    f32x4 xo = *(const f32x4*)(xold + (size_t)tok * DM + n);
                    f32x4 xn;
                    xn[0] = xo[0] + acc[mi][ni][4 * j + 0]; xn[1] = xo[1] + acc[mi][ni][4 * j + 1];
                    xn[2] = xo[2] + acc[mi][ni][4 * j + 2]; xn[3] = xo[3] + acc[mi][ni][4 * j + 3];
                    s += xn[0] * xn[0] + xn[1] * xn[1] + xn[2] * xn[2] + xn[3] * xn[3];
                    *(f32x4*)(p.out + (size_t)tok * DM + n) = xn;
                    *(u32x2*)(XB + (size_t)tok * DM + n) = (u32x2){pk_bf16(xn[0], xn[1]), pk_bf16(xn[2], xn[3])};
                }
            s += shfl_xor32(s);
            if (g == 0) ssq[(size_t)tok * 16 + nt * 2 + wn] = s;
        }
    }
}

constexpr int USTR = 132;
__device__ void phase_up(const Params& p, int l, char* smem) {
    const int tid = opaque_tid(), lane = tid & 63, wave = tid >> 6, wm = wave >> 1, wn = wave & 1, g = lane >> 5, q = lane & 31;
    const bf16_t* XB = (const bf16_t*)(p.ws + OFF_XB);
    const bf16_t* WT = (const bf16_t*)(p.ws + OFF_WT_UP + l * SZ_WT_UP);
    const float* ssq = (const float*)(p.ws + OFF_SSQ_FFN);
    bf16_t* H = (bf16_t*)(p.ws + OFF_GATES);
    const float* cw = p.conv_w + (size_t)l * 3 * DFF2;
    const float* cb = p.conv_b + (size_t)l * DFF2;
    float* Us = (float*)smem;
    for (int t = blockIdx.x; t < 132 * 44; t += gridDim.x) {
        int mt, nt;
        tile_order(t, 132, 44, mt, nt);
        const int b = mt / 33, ti = mt % 33;
        const int pos0 = -2 + 126 * ti;
        const int n0 = nt * 128;
        int aoff[4], boff[4];
#pragma unroll
        for (int i = 0; i < 4; ++i) {
            const int row = (tid >> 3) + 32 * i, ch = tid & 7;
            int pos = pos0 + row;
            pos = pos < 0 ? 0 : (pos > SEQ - 1 ? SEQ - 1 : pos);
            aoff[i] = (b * SEQ + pos) * DM + ch * 8;
            boff[i] = (n0 + row) * DM + ch * 8;
        }
        f32x16 acc[2][2];
        zero_acc(acc);
        gemm_mainloop<false>(acc, XB, aoff, WT, boff, DM / 64, smem);
#pragma unroll
        for (int mi = 0; mi < 2; ++mi) {
            const int rl = wm * 64 + 32 * mi + q;
            int pos = pos0 + rl;
            const bool zero = pos < 0;
            pos = pos < 0 ? 0 : (pos > SEQ - 1 ? SEQ - 1 : pos);
            float rs = __builtin_amdgcn_rsqf(row_ssq(ssq, b * SEQ + pos) * (1.0f / DM) + EPS);
            if (zero) rs = 0.f;
#pragma unroll
            for (int ni = 0; ni < 2; ++ni)
#pragma unroll
                for (int j = 0; j < 4; ++j) {
                    const int nl = wn * 64 + 32 * ni + 8 * j + 4 * g;
                    f32x4 v;
                    v[0] = acc[mi][ni][4 * j + 0] * rs; v[1] = acc[mi][ni][4 * j + 1] * rs;
                    v[2] = acc[mi][ni][4 * j + 2] * rs; v[3] = acc[mi][ni][4 * j + 3] * rs;
                    *(f32x4*)(Us + rl * USTR + nl) = v;
                }
        }
        __syncthreads();
        {
            const int j4 = (tid & 15) * 4, rb = tid >> 4;
            const int jg = nt * 64 + j4;
            f32x4 wg[3], wv[3], bg, bv;
#pragma unroll
            for (int i = 0; i < 3; ++i) { wg[i] = *(const f32x4*)(cw + i * DFF2 + jg); wv[i] = *(const f32x4*)(cw + i * DFF2 + DFF + jg); }
            bg = *(const f32x4*)(cb + jg);
            bv = *(const f32x4*)(cb + DFF + jg);
#pragma unroll
            for (int i = 0; i < 8; ++i) {
                const int r = rb + 16 * i;
                const int pos = pos0 + r;
                if (r >= 2 && pos < SEQ) {
                    f32x4 cg_ = bg, cv_ = bv;
#pragma unroll
                    for (int jj = 0; jj < 3; ++jj) {
                        f32x4 ug = *(const f32x4*)(Us + (r - 2 + jj) * USTR + j4);
                        f32x4 uv = *(const f32x4*)(Us + (r - 2 + jj) * USTR + 64 + j4);
                        cg_ += ug * wg[jj];
                        cv_ += uv * wv[jj];
                    }
                    float h0 = cg_[0] * fast_sigmoid(cg_[0]) * cv_[0], h1 = cg_[1] * fast_sigmoid(cg_[1]) * cv_[1],
                          h2 = cg_[2] * fast_sigmoid(cg_[2]) * cv_[2], h3 = cg_[3] * fast_sigmoid(cg_[3]) * cv_[3];
                    *(u32x2*)(H + (size_t)(b * SEQ + pos) * DFF + jg) = (u32x2){pk_bf16(h0, h1), pk_bf16(h2, h3)};
                }
            }
        }
    }
}

__device__ void phase_final(const Params& p) {
    const int tid = opaque_tid(), lane = tid & 63, wave = tid >> 6;
    const float* ssq = (const float*)(p.ws + OFF_SSQ_MIX);
    for (int row = blockIdx.x * 4 + wave; row < NTOK; row += gridDim.x * 4) {
        float* xr = p.out + (size_t)row * DM;
        const float rs = __builtin_amdgcn_rsqf(row_ssq(ssq, row) * (1.0f / DM) + EPS);
#pragma unroll
        for (int i = 0; i < 4; ++i) {
            f32x4 v = *(const f32x4*)(xr + i * 256 + lane * 4);
            f32x4 w = *(const f32x4*)(p.norm_final_w + i * 256 + lane * 4);
            v[0] *= rs * w[0]; v[1] *= rs * w[1]; v[2] *= rs * w[2]; v[3] *= rs * w[3];
            *(f32x4*)(xr + i * 256 + lane * 4) = v;
        }
    }
}

__global__ void __launch_bounds__(256, 2) mega_kernel(Params p, int phase_lo, int phase_hi, int use_sync) {
    __shared__ __attribute__((aligned(16))) char smem[SMEM_BYTES];
    __shared__ int s_item;
    cg::grid_group grid = cg::this_grid();
    int ph = 0;
#define PHASE_BEGIN if (ph >= phase_lo && ph < phase_hi) {
#define PHASE_END   if (use_sync) { __threadfence(); grid.sync(); __threadfence(); } } ++ph;
    PHASE_BEGIN phase_convert(p, smem); PHASE_END
    for (int l = 0; l < DEPTH; ++l) {
        const float lam_init = 0.8f - 0.6f * expf(-0.3f * (float)l);
        float d1 = 0.f, d2 = 0.f;
        for (int i = 0; i < 64; ++i) { d1 += p.lq1[l * 64 + i] * p.lk1[l * 64 + i]; d2 += p.lq2[l * 64 + i] * p.lk2[l * 64 + i]; }
        const float lam = expf(d1) - expf(d2) + lam_init;
        PHASE_BEGIN phase_inproj(p, l, smem); PHASE_END
        PHASE_BEGIN phase_attn(p, l, lam, lam_init, smem, &s_item); PHASE_END
        PHASE_BEGIN phase_branch(p, l, smem); PHASE_END
        PHASE_BEGIN phase_resid(p, (const bf16_t*)(p.ws + OFF_QKDA), 1024, (const bf16_t*)(p.ws + OFF_WT_MIX + l * SZ_WT_MIX), 1024,
                                l == 0 ? p.x : p.out, (float*)(p.ws + OFF_SSQ_FFN), smem); PHASE_END
        PHASE_BEGIN phase_up(p, l, smem); PHASE_END
        PHASE_BEGIN phase_resid(p, (const bf16_t*)(p.ws + OFF_GATES), DFF, (const bf16_t*)(p.ws + OFF_WT_DN + l * SZ_WT_DN), DFF, p.out,
                                (float*)(p.ws + OFF_SSQ_MIX), smem); PHASE_END
    }
    if (ph >= phase_lo && ph < phase_hi) phase_final(p);
}

__global__ void dump_kernel(const bf16_t* src, float* out) {
    for (size_t i = (size_t)blockIdx.x * 256 + threadIdx.x; i < (size_t)NTOK * DM; i += (size_t)gridDim.x * 256)
        out[i] = __uint_as_float(((unsigned)src[i]) << 16);
}

extern "C" void kernel_launch(void* const* d_in, const int* in_sizes, int n_in, void* d_out, int out_size, void* d_ws, size_t ws_size,
                              hipStream_t stream) {
    static int grid_blocks = 0;
    if (!grid_blocks) {
        int dev = 0, cus = 0, per_cu = 0;
        hipGetDevice(&dev);
        hipDeviceGetAttribute(&cus, hipDeviceAttributeMultiprocessorCount, dev);
        hipOccupancyMaxActiveBlocksPerMultiprocessor(&per_cu, mega_kernel, 256, 0);
        if (per_cu > 2) per_cu = 2;
        if (per_cu < 1) per_cu = 1;
        grid_blocks = cus * per_cu;
    }
    Params p{};
    const float* const* in = (const float* const*)d_in;
    p.x = in[0]; p.norm_mix_w = in[1]; p.w_in = in[2]; p.lq1 = in[3]; p.lk1 = in[4]; p.lq2 = in[5]; p.lk2 = in[6];
    p.subln_w = in[7]; p.sinks = in[8]; p.w_br_da = in[9]; p.w_br_sw = in[10]; p.w_mix_out = in[11]; p.norm_ffn_w = in[12];
    p.w_up = in[13]; p.conv_w = in[14]; p.conv_b = in[15]; p.w_down = in[16]; p.norm_final_w = in[17];
    p.out = (float*)d_out;
    p.ws = (char*)d_ws;
    if (ws_size < WS_TOTAL) { fprintf(stderr, "workspace too small: %zu < %zu\n", ws_size, (size_t)WS_TOTAL); return; }
#ifndef MULTI_LAUNCH
#define MULTI_LAUNCH 1
#endif
#if MULTI_LAUNCH
#ifdef DBG_STOP
    for (int ph = 0; ph <= DBG_STOP; ++ph) mega_kernel<<<dim3(grid_blocks), dim3(256), 0, stream>>>(p, ph, ph + 1, 0);
    if (DBG_OFF != 0) dump_kernel<<<dim3(4096), dim3(256), 0, stream>>>((const bf16_t*)(p.ws + DBG_OFF), p.out);
#else
    for (int ph = 0; ph < 2 + 6 * DEPTH; ++ph) mega_kernel<<<dim3(grid_blocks), dim3(256), 0, stream>>>(p, ph, ph + 1, 0);
#endif
#else
    int lo = 0, hi = 1000, us = 1;
    void* args[] = {&p, &lo, &hi, &us};
    hipError_t e = hipLaunchCooperativeKernel((void*)mega_kernel, dim3(grid_blocks), dim3(256), args, 0, stream);
    if (e != hipSuccess) fprintf(stderr, "cooperative launch failed: %s (grid %d)\n", hipGetErrorString(e), grid_blocks);
#endif
}
```

```cpp
#include <hip/hip_runtime.h>
#include <hip/hip_cooperative_groups.h>
#include <cstdio>
namespace cg = cooperative_groups;

typedef unsigned short bf16_t;
typedef short bf16x8 __attribute__((ext_vector_type(8)));
typedef float f32x16 __attribute__((ext_vector_type(16)));
typedef float f32x4 __attribute__((ext_vector_type(4)));
typedef unsigned u32x4 __attribute__((ext_vector_type(4)));
typedef unsigned u32x2 __attribute__((ext_vector_type(2)));

#define DEVI __device__ __forceinline__

constexpr int DM = 1024, NTOK = 16384, SEQ = 4096, DEPTH = 4;
constexpr int INC = 4352, DFF = 2816, DFF2 = 5632;
constexpr float EPS = 1e-6f;
constexpr float LOG2E = 1.4426950408889634f;
constexpr float QSCALE = 0.125f * LOG2E;

constexpr size_t SZ_WT_IN = (size_t)INC * DM * 2, SZ_WT_BR = (size_t)DM * 512 * 2, SZ_WT_MIX = (size_t)DM * DM * 2,
                 SZ_WT_UP = (size_t)DFF2 * DM * 2, SZ_WT_DN = (size_t)DM * DFF * 2;
constexpr size_t OFF_WT_IN = 0;
constexpr size_t OFF_WT_DA = OFF_WT_IN + DEPTH * SZ_WT_IN;
constexpr size_t OFF_WT_SW = OFF_WT_DA + DEPTH * SZ_WT_BR;
constexpr size_t OFF_WT_MIX = OFF_WT_SW + DEPTH * SZ_WT_BR;
constexpr size_t OFF_WT_UP = OFF_WT_MIX + DEPTH * SZ_WT_MIX;
constexpr size_t OFF_WT_DN = OFF_WT_UP + DEPTH * SZ_WT_UP;
constexpr size_t OFF_XB = OFF_WT_DN + DEPTH * SZ_WT_DN;
constexpr size_t OFF_SSQ_MIX = OFF_XB + (size_t)NTOK * DM * 2;
constexpr size_t OFF_SSQ_FFN = OFF_SSQ_MIX + (size_t)NTOK * 16 * 4;
constexpr size_t OFF_CTR = OFF_SSQ_FFN + (size_t)NTOK * 16 * 4;
constexpr size_t OFF_QKDA = OFF_CTR + 256;
constexpr size_t OFF_VTDA = OFF_QKDA + (size_t)NTOK * 1024 * 2;
constexpr size_t OFF_QSW = OFF_VTDA + (size_t)NTOK * 512 * 2;
constexpr size_t OFF_KSW = OFF_QSW + (size_t)NTOK * 512 * 2;
constexpr size_t OFF_VTSW = OFF_KSW + (size_t)NTOK * 128 * 2;
constexpr size_t OFF_GATES = OFF_VTSW + (size_t)NTOK * 128 * 2;
constexpr size_t OFF_Y = OFF_GATES + (size_t)NTOK * 2048 * 2;
constexpr size_t WS_TOTAL = OFF_Y + (size_t)NTOK * 1024 * 2;

struct Params {
    const float *x, *norm_mix_w, *w_in, *lq1, *lk1, *lq2, *lk2, *subln_w, *sinks, *w_br_da, *w_br_sw, *w_mix_out,
        *norm_ffn_w, *w_up, *conv_w, *conv_b, *w_down, *norm_final_w;
    float* out;
    char* ws;
};

constexpr int NTHR = 512;
constexpr int RSTD_OFF = 147456;
constexpr int SMEM_BYTES = 147456 + 2048;

typedef __bf16 bf16v2 __attribute__((ext_vector_type(2)));
typedef float f32x2 __attribute__((ext_vector_type(2)));
DEVI unsigned pk_bf16(float lo, float hi) {
    bf16v2 r = __builtin_convertvector((f32x2){lo, hi}, bf16v2);
    return __builtin_bit_cast(unsigned, r);
}
DEVI float bf2f_lo(unsigned u) { return __uint_as_float(u << 16); }
DEVI float bf2f_hi(unsigned u) { return __uint_as_float(u & 0xffff0000u); }
DEVI float fast_sigmoid(float x) { return __builtin_amdgcn_rcpf(1.0f + __builtin_amdgcn_exp2f(-x * LOG2E)); }
DEVI float sum_halves(float v) {
    u32x2 r = __builtin_amdgcn_permlane32_swap(__float_as_uint(v), __float_as_uint(v), false, false);
    return __uint_as_float(r[0]) + __uint_as_float(r[1]);
}
DEVI float max_halves(float v) {
    u32x2 r = __builtin_amdgcn_permlane32_swap(__float_as_uint(v), __float_as_uint(v), false, false);
    return fmaxf(__uint_as_float(r[0]), __uint_as_float(r[1]));
}
DEVI float row_ssq(const float* __restrict__ ssq, int tok) {
    const f32x4 a = *(const f32x4*)(ssq + (size_t)tok * 16), b = *(const f32x4*)(ssq + (size_t)tok * 16 + 4),
                c = *(const f32x4*)(ssq + (size_t)tok * 16 + 8), d = *(const f32x4*)(ssq + (size_t)tok * 16 + 12);
    return ((a[0] + a[1]) + (a[2] + a[3])) + ((b[0] + b[1]) + (b[2] + b[3])) + ((c[0] + c[1]) + (c[2] + c[3])) + ((d[0] + d[1]) + (d[2] + d[3]));
}
DEVI int opaque_tid() { int t = threadIdx.x; asm volatile("" : "+v"(t)); return t; }

__device__ void convert_weights(const Params& p, char* smem, int l_lo, int l_hi, int vb, int nvb) {
    const int tid = opaque_tid();
    const int half = tid >> 8, ht = tid & 255;
    float* T = (float*)smem + half * (64 * 65);
    const int total = (l_hi - l_lo) * 3712;
    const int iters = (total + 2 * nvb - 1) / (2 * nvb);
    for (int it = 0; it < iters; ++it) {
        const int t = (it * nvb + vb) * 2 + half;
        const bool act = t < total;
        const int l = l_lo + (act ? t / 3712 : 0);
        int r = act ? t % 3712 : 0;
        const float* W;
        const float* sc = nullptr;
        bf16_t* D;
        int K, N, mode = 0, scmask = 0x7fffffff;
        float scmul = 1.0f;
        if (r < 1088) {
            W = p.w_in + (size_t)l * DM * INC; K = DM; N = INC; sc = p.norm_mix_w + l * DM;
            D = (bf16_t*)(p.ws + OFF_WT_IN + l * SZ_WT_IN);
        } else if ((r -= 1088) < 128) {
            W = p.w_br_da + (size_t)l * 512 * DM; K = 512; N = DM; D = (bf16_t*)(p.ws + OFF_WT_DA + l * SZ_WT_BR);
            sc = p.subln_w + l * 128; scmask = 127; scmul = 1.0f - (0.8f - 0.6f * expf(-0.3f * (float)l));
        } else if ((r -= 128) < 128) {
            W = p.w_br_sw + (size_t)l * 512 * DM; K = 512; N = DM; D = (bf16_t*)(p.ws + OFF_WT_SW + l * SZ_WT_BR);
        } else if ((r -= 128) < 256) {
            W = p.w_mix_out + (size_t)l * DM * DM; K = DM; N = DM; D = (bf16_t*)(p.ws + OFF_WT_MIX + l * SZ_WT_MIX);
        } else if ((r -= 256) < 1408) {
            W = p.w_up + (size_t)l * DM * DFF2; K = DM; N = DFF2; sc = p.norm_ffn_w + l * DM; mode = 1;
            D = (bf16_t*)(p.ws + OFF_WT_UP + l * SZ_WT_UP);
        } else {
            r -= 1408;
            W = p.w_down + (size_t)l * DFF * DM; K = DFF; N = DM; D = (bf16_t*)(p.ws + OFF_WT_DN + l * SZ_WT_DN);
        }
        const int ntn = N >> 6;
        const int k0 = (r / ntn) * 64, n0 = (r % ntn) * 64;
        __syncthreads();
        if (act) {
#pragma unroll
            for (int i = 0; i < 4; ++i) {
                const int kr = (ht >> 4) + 16 * i, c4 = (ht & 15) * 4;
                f32x4 v = *(const f32x4*)(W + (size_t)(k0 + kr) * N + n0 + c4);
                const float s_ = sc ? sc[(k0 + kr) & scmask] * scmul : 1.0f;
                T[kr * 65 + c4 + 0] = v[0] * s_; T[kr * 65 + c4 + 1] = v[1] * s_;
                T[kr * 65 + c4 + 2] = v[2] * s_; T[kr * 65 + c4 + 3] = v[3] * s_;
            }
        }
        __syncthreads();
        if (act) {
            const int nl = ht >> 2, kc = (ht & 3) * 16;
            int n = n0 + nl;
            if (mode == 1) n = (n < DFF) ? ((n >> 7) * 256 + (n & 127)) : (((n - DFF) >> 7) * 256 + 128 + ((n - DFF) & 127));
            unsigned o[8];
#pragma unroll
            for (int e = 0; e < 8; ++e) o[e] = pk_bf16(T[(kc + 2 * e) * 65 + nl], T[(kc + 2 * e + 1) * 65 + nl]);
            bf16_t* dst = D + (size_t)n * K + k0 + kc;
            *(u32x4*)dst = (u32x4){o[0], o[1], o[2], o[3]};
            *(u32x4*)(dst + 8) = (u32x4){o[4], o[5], o[6], o[7]};
        }
    }
}

__device__ void phase_convert(const Params& p, char* smem) {
    convert_weights(p, smem, 0, 1, blockIdx.x, gridDim.x);
    const int tid = opaque_tid();
    {
        const int lane = tid & 63, wave = tid >> 6;
        bf16_t* XB = (bf16_t*)(p.ws + OFF_XB);
        float* ssq = (float*)(p.ws + OFF_SSQ_MIX);
        for (int row = blockIdx.x * 8 + wave; row < NTOK; row += gridDim.x * 8) {
            const float* xr = p.x + (size_t)row * DM;
            float s = 0.f;
#pragma unroll
            for (int i = 0; i < 4; ++i) {
                f32x4 v = *(const f32x4*)(xr + i * 256 + lane * 4);
                s += v[0] * v[0] + v[1] * v[1] + v[2] * v[2] + v[3] * v[3];
                *(u32x2*)(XB + (size_t)row * DM + i * 256 + lane * 4) = (u32x2){pk_bf16(v[0], v[1]), pk_bf16(v[2], v[3])};
            }
#pragma unroll
            for (int o = 32; o >= 1; o >>= 1) s += __shfl_xor(s, o, 64);
            if (lane < 16) ssq[(size_t)row * 16 + lane] = (lane == 0) ? s : 0.f;
        }
    }
}

constexpr int BM = 256, BN = 256, BK = 64;
constexpr int TROWB = 144;
constexpr int TA = BM * TROWB;
constexpr int TSTAGE = (BM + BN) * TROWB;
template <bool SWAP, bool PIPE>
DEVI void gemm_compute(f32x16 (&acc)[4][2], const char* S, int a_rd, int b_rd) {
    if (PIPE) {
        bf16x8 af[2][4], bf[2][2];
#pragma unroll
        for (int mi = 0; mi < 4; ++mi) af[0][mi] = *(const bf16x8*)(S + a_rd + mi * 32 * TROWB);
#pragma unroll
        for (int ni = 0; ni < 2; ++ni) bf[0][ni] = *(const bf16x8*)(S + b_rd + ni * 32 * TROWB);
#pragma unroll
        for (int kk = 0; kk < 4; ++kk) {
            const int c = kk & 1, n = c ^ 1;
            if (kk < 3) {
#pragma unroll
                for (int mi = 0; mi < 4; ++mi) af[n][mi] = *(const bf16x8*)(S + a_rd + mi * 32 * TROWB + (kk + 1) * 32);
#pragma unroll
                for (int ni = 0; ni < 2; ++ni) bf[n][ni] = *(const bf16x8*)(S + b_rd + ni * 32 * TROWB + (kk + 1) * 32);
            }
            __builtin_amdgcn_sched_barrier(0);
#pragma unroll
            for (int mi = 0; mi < 4; ++mi)
#pragma unroll
                for (int ni = 0; ni < 2; ++ni) {
                    if (SWAP) acc[mi][ni] = __builtin_amdgcn_mfma_f32_32x32x16_bf16(af[c][mi], bf[c][ni], acc[mi][ni], 0, 0, 0);
                    else acc[mi][ni] = __builtin_amdgcn_mfma_f32_32x32x16_bf16(bf[c][ni], af[c][mi], acc[mi][ni], 0, 0, 0);
                }
            __builtin_amdgcn_sched_barrier(0);
        }
    } else {
#pragma unroll
        for (int kk = 0; kk < 4; ++kk) {
            if (kk == 2) __builtin_amdgcn_sched_barrier(0);
            bf16x8 af[4], bf[2];
#pragma unroll
            for (int mi = 0; mi < 4; ++mi) af[mi] = *(const bf16x8*)(S + a_rd + mi * 32 * TROWB + kk * 32);
#pragma unroll
            for (int ni = 0; ni < 2; ++ni) bf[ni] = *(const bf16x8*)(S + b_rd + ni * 32 * TROWB + kk * 32);
#pragma unroll
            for (int mi = 0; mi < 4; ++mi)
#pragma unroll
                for (int ni = 0; ni < 2; ++ni) {
                    if (SWAP) acc[mi][ni] = __builtin_amdgcn_mfma_f32_32x32x16_bf16(af[mi], bf[ni], acc[mi][ni], 0, 0, 0);
                    else acc[mi][ni] = __builtin_amdgcn_mfma_f32_32x32x16_bf16(bf[ni], af[mi], acc[mi][ni], 0, 0, 0);
                }
        }
    }
}
DEVI void stage_offsets(int (&off)[4], int row0, int ld, int tid) {
#pragma unroll
    for (int i = 0; i < 4; ++i) off[i] = (row0 + (tid >> 3) + 64 * i) * ld + (tid & 7) * 8;
}
template <bool PIPE>
DEVI void gemm_mainloop(f32x16 (&acc)[4][2], const bf16_t* __restrict__ A, const int (&aoff)[4], const bf16_t* __restrict__ B,
                        const int (&boff)[4], int nk, char* smem, bool swap) {
    const int tid = opaque_tid(), lane = tid & 63, wave = tid >> 6;
    const int wm = wave >> 2, wn = wave & 3;
    const int g = lane >> 5, q = lane & 31;
    const int st_off = (tid >> 3) * TROWB + (tid & 7) * 16;
    const int a_rd = (wm * 128 + q) * TROWB + g * 16;
    const int b_rd = TA + (wn * 64 + q) * TROWB + g * 16;
    u32x4 ra[4], rb[4];
#define GLOAD(KT)                                                                              \
    {                                                                                          \
        _Pragma("unroll") for (int i = 0; i < 4; ++i) ra[i] = *(const u32x4*)(A + aoff[i] + (KT) * BK); \
        _Pragma("unroll") for (int i = 0; i < 4; ++i) rb[i] = *(const u32x4*)(B + boff[i] + (KT) * BK); \
    }
#define LSTORE(BUF)                                                                            \
    {                                                                                          \
        char* D_ = smem + (BUF) * TSTAGE;                                                      \
        _Pragma("unroll") for (int i = 0; i < 4; ++i) *(u32x4*)(D_ + st_off + i * 64 * TROWB) = ra[i];      \
        _Pragma("unroll") for (int i = 0; i < 4; ++i) *(u32x4*)(D_ + TA + st_off + i * 64 * TROWB) = rb[i]; \
    }
    GLOAD(0)
    __syncthreads();
    LSTORE(0)
    GLOAD(nk > 1 ? 1 : 0)
    __syncthreads();
    for (int kt = 0; kt < nk; ++kt) {
        const int cur = kt & 1;
        LSTORE(cur ^ 1)
        const int kn = (kt + 2 < nk) ? kt + 2 : nk - 1;
        GLOAD(kn)
        __builtin_amdgcn_sched_barrier(0);
        if (swap) gemm_compute<true, PIPE>(acc, smem + cur * TSTAGE, a_rd, b_rd); else gemm_compute<false, PIPE>(acc, smem + cur * TSTAGE, a_rd, b_rd);
        __builtin_amdgcn_sched_barrier(0);
        __syncthreads();
    }
#undef GLOAD
#undef LSTORE
}

DEVI void zero_acc(f32x16 (&acc)[4][2]) {
#pragma unroll
    for (int mi = 0; mi < 4; ++mi)
#pragma unroll
        for (int ni = 0; ni < 2; ++ni)
#pragma unroll
            for (int r = 0; r < 16; ++r) acc[mi][ni][r] = 0.f;
}

DEVI int virt_block() { return (blockIdx.x & 7) * (gridDim.x >> 3) + (blockIdx.x >> 3); }
DEVI void tile_order(int t, int MT, int NT, int& mt, int& nt) {
    const int grp = t / (8 * NT);
    const int first = grp * 8;
    const int gsz = (MT - first) < 8 ? (MT - first) : 8;
    const int rem = t - grp * 8 * NT;
    mt = first + rem % gsz;
    nt = rem / gsz;
}

__device__ void phase_inproj(const Params& p, int l, char* smem) {
    const int tid = opaque_tid(), lane = tid & 63, wave = tid >> 6, wm = wave >> 2, wn = wave & 3, g = lane >> 5, q = lane & 31;
    const bf16_t* XB = (const bf16_t*)(p.ws + OFF_XB);
    const bf16_t* WT = (const bf16_t*)(p.ws + OFF_WT_IN + l * SZ_WT_IN);
    const float* ssq = (const float*)(p.ws + OFF_SSQ_MIX);
    int tpar = 0;
    for (int t = virt_block(); t < 64 * 17; t += gridDim.x) {
        int mt, nt;
        tile_order(t, 64, 17, mt, nt);
        const int m0 = mt * BM, n0 = nt * BN;
        int aoff[4], boff[4];
        stage_offsets(aoff, m0, DM, tid);
        stage_offsets(boff, n0, DM, tid);
        f32x16 acc[4][2];
        zero_acc(acc);
        float* rstd_s = (float*)(smem + RSTD_OFF) + (tpar & 1) * 256;
        ++tpar;
        if (tid < 256) rstd_s[tid] = __builtin_amdgcn_rsqf(row_ssq(ssq, m0 + tid) * (1.0f / DM) + EPS);
        const int cb = n0 + wn * 64;
        const bool isv = (cb >= 1024 && cb < 1536) || (cb >= 2176 && cb < 2304);
        gemm_mainloop<true>(acc, XB, aoff, WT, boff, DM / BK, smem, isv);
        if (!isv) {
            bf16_t* dst; int ld, coff; int mode;
            if (cb < 512) { dst = (bf16_t*)(p.ws + OFF_QKDA); ld = 1024; coff = cb; mode = 0; }
            else if (cb < 1024) { dst = (bf16_t*)(p.ws + OFF_QKDA); ld = 1024; coff = cb; mode = 1; }
            else if (cb < 2048) { dst = (bf16_t*)(p.ws + OFF_QSW); ld = 512; coff = cb - 1536; mode = 0; }
            else if (cb < 2176) { dst = (bf16_t*)(p.ws + OFF_KSW); ld = 128; coff = cb - 2048; mode = 1; }
            else { dst = (bf16_t*)(p.ws + OFF_GATES); ld = 2048; coff = cb - 2304; mode = 2; }
#pragma unroll
            for (int mi = 0; mi < 4; ++mi) {
                const int tok = m0 + wm * 128 + 32 * mi + q;
                float rs = rstd_s[wm * 128 + 32 * mi + q];
                if (mode == 0) rs *= QSCALE;
#pragma unroll
                for (int ni = 0; ni < 2; ++ni)
#pragma unroll
                    for (int j = 0; j < 4; ++j) {
                        float v0 = acc[mi][ni][4 * j + 0] * rs, v1 = acc[mi][ni][4 * j + 1] * rs, v2 = acc[mi][ni][4 * j + 2] * rs,
                              v3 = acc[mi][ni][4 * j + 3] * rs;
                        if (mode == 2) { v0 = fast_sigmoid(v0); v1 = fast_sigmoid(v1); v2 = fast_sigmoid(v2); v3 = fast_sigmoid(v3); }
                        const int nl = 32 * ni + 8 * j + 4 * g;
                        *(u32x2*)(dst + (size_t)tok * ld + coff + nl) = (u32x2){pk_bf16(v0, v1), pk_bf16(v2, v3)};
                    }
            }
        } else {
            bf16_t* dst; int rowbase;
            const int b = m0 >> 12, s0 = m0 & 4095;
            int rows_per_b;
            if (cb < 1536) { dst = (bf16_t*)(p.ws + OFF_VTDA); rowbase = cb - 1024; rows_per_b = 512; }
            else { dst = (bf16_t*)(p.ws + OFF_VTSW); rowbase = cb - 2176; rows_per_b = 128; }
#pragma unroll
            for (int mi = 0; mi < 4; ++mi)
#pragma unroll
                for (int j = 0; j < 4; ++j) {
                    const int sl = wm * 128 + 32 * mi + 8 * j + 4 * g;
                    const f32x4 rq = *(const f32x4*)(rstd_s + sl);
                    const float r0 = rq[0], r1 = rq[1], r2 = rq[2], r3 = rq[3];
#pragma unroll
                    for (int ni = 0; ni < 2; ++ni) {
                        const int nl = 32 * ni + q;
                        bf16_t* d = dst + ((size_t)(b * rows_per_b + rowbase + nl)) * SEQ + s0 + sl;
                        *(u32x2*)d = (u32x2){pk_bf16(acc[mi][ni][4 * j + 0] * r0, acc[mi][ni][4 * j + 1] * r1),
                                             pk_bf16(acc[mi][ni][4 * j + 2] * r2, acc[mi][ni][4 * j + 3] * r3)};
                    }
                }
        }
    }
    if (l + 1 < DEPTH) {
        const int ntile = 64 * 17, g_ = gridDim.x, busy = ntile % g_;
        const int vb = virt_block();
        if (busy > 0 && busy < g_) {
            if (vb >= busy) { __syncthreads(); convert_weights(p, smem, l + 1, l + 2, vb - busy, g_ - busy); }
        } else {
            __syncthreads();
            convert_weights(p, smem, l + 1, l + 2, vb, g_);
        }
    }
}

#define CJI(r) (16 * ((r) >> 3) + ((r) & 7))
template <int KROWB, int VROWB, int DV, bool SW>
DEVI void attn_sub(f32x16 (&O)[DV / 32], float& m, float& lsum, const bf16x8 (&qf)[4], const char* Ksub, const char* Vsub, int ks0, int qw,
                   int qpos, int g, float slope2) {
    constexpr int NB = DV / 32;
    const int relbase = ks0 + 8 * g - qpos;
    const float basef = slope2 * (float)relbase;
    const bool need_mask = SW || (ks0 + 31 > qw);
    bf16x8 kf[4], vf[2][NB];
#pragma unroll
    for (int kk = 0; kk < 4; ++kk) kf[kk] = *(const bf16x8*)(Ksub + kk * 32);
#pragma unroll
    for (int t = 0; t < 2; ++t)
#pragma unroll
        for (int b = 0; b < NB; ++b) vf[t][b] = *(const bf16x8*)(Vsub + b * 32 * VROWB + t * 32);
    __builtin_amdgcn_sched_barrier(0);
    f32x16 S;
#pragma unroll
    for (int r = 0; r < 16; ++r) S[r] = __builtin_fmaf(slope2, (float)CJI(r), basef);
#pragma unroll
    for (int kk = 0; kk < 4; ++kk) S = __builtin_amdgcn_mfma_f32_32x32x16_bf16(kf[kk], qf[kk], S, 0, 0, 0);
    if (need_mask) {
#pragma unroll
        for (int r = 0; r < 16; ++r) {
            const int rel = relbase + CJI(r);
            bool valid = rel <= 0;
            if (SW) valid = valid && (rel > -128) && (rel + qpos >= 0);
            S[r] = valid ? S[r] : -1e30f;
        }
    }
    float mx = S[0];
#pragma unroll
    for (int r = 1; r < 16; ++r) mx = fmaxf(mx, S[r]);
    mx = max_halves(mx);
    if (__builtin_amdgcn_ballot_w64(mx > m + 12.0f) != 0ull) {
        const float mn = fmaxf(m, mx);
        const float alpha = __builtin_amdgcn_exp2f(m - mn);
        m = mn;
        lsum *= alpha;
#pragma unroll
        for (int b = 0; b < NB; ++b)
#pragma unroll
            for (int r = 0; r < 16; ++r) O[b][r] *= alpha;
    }
    float ps = 0.f;
#pragma unroll
    for (int r = 0; r < 16; ++r) { S[r] = __builtin_amdgcn_exp2f(S[r] - m); ps += S[r]; }
    lsum += ps;
    bf16x8 P[2];
#pragma unroll
    for (int t = 0; t < 2; ++t) {
        u32x4 pk = (u32x4){pk_bf16(S[8 * t + 0], S[8 * t + 1]), pk_bf16(S[8 * t + 2], S[8 * t + 3]), pk_bf16(S[8 * t + 4], S[8 * t + 5]),
                           pk_bf16(S[8 * t + 6], S[8 * t + 7])};
        P[t] = __builtin_bit_cast(bf16x8, pk);
    }
#pragma unroll
    for (int t = 0; t < 2; ++t)
#pragma unroll
        for (int b = 0; b < NB; ++b) O[b] = __builtin_amdgcn_mfma_f32_32x32x16_bf16(vf[t][b], P[t], O[b], 0, 0, 0);
}

template <int KW, int DV, bool SW>
DEVI void attn_item(const bf16_t* __restrict__ Qp, int ldq, const bf16_t* __restrict__ Kp, int ldk, const bf16_t* __restrict__ VTp,
                    bf16_t* __restrict__ Yp, int ldy, int qw, int map, int kbeg, int kend, float slope2, float sink2, float lam, char* smem) {
    constexpr int KROWB = KW * 128 + 16;
    constexpr int VROWB = 272;
    constexpr int KCH = KW * 8;
    constexpr int NB = DV / 32;
    constexpr int KN = (128 * KCH) / NTHR, VN = (DV * 16) / NTHR;
    constexpr int ASTAGE = 128 * KROWB + DV * VROWB;
    const int tid = opaque_tid(), lane = tid & 63, q = lane & 31, g = lane >> 5, wave = __builtin_amdgcn_readfirstlane(tid >> 6);
    const int qpos = qw + q;
    bf16x8 qf[4];
#pragma unroll
    for (int kk = 0; kk < 4; ++kk) qf[kk] = *(const bf16x8*)(Qp + (size_t)qpos * ldq + map * 64 + kk * 16 + g * 8);
    f32x16 O[NB];
#pragma unroll
    for (int b = 0; b < NB; ++b)
#pragma unroll
        for (int r = 0; r < 16; ++r) O[b][r] = 0.f;
    float m = SW ? sink2 : -1e30f, lsum = (SW && g == 0) ? 1.f : 0.f;
    const int pr = (q & 0x13) | ((q & 4) << 1) | ((q & 8) >> 1);
    const int kw_off = pr * KROWB + g * 16 + map * 128;
    const int vw_off = 128 * KROWB + q * VROWB + g * 16;
    u32x4 kreg[KN], vreg[VN];
#define ATT_GLOAD(KT0)                                                                         \
    {                                                                                          \
        _Pragma("unroll") for (int i = 0; i < KN; ++i) {                                       \
            const int id = tid + NTHR * i, row = id / KCH, ch = id % KCH;                      \
            int tok = (KT0) + row;                                                             \
            tok = tok < 0 ? 0 : (tok > SEQ - 1 ? SEQ - 1 : tok);                               \
            kreg[i] = *(const u32x4*)(Kp + (size_t)tok * ldk + ch * 8);                        \
        }                                                                                      \
        _Pragma("unroll") for (int i = 0; i < VN; ++i) {                                       \
            const int id = tid + NTHR * i, r = id >> 4, ch = id & 15;                          \
            int s_ = (KT0) + ch * 8;                                                           \
            s_ = s_ < 0 ? 0 : (s_ > SEQ - 8 ? SEQ - 8 : s_);                                   \
            vreg[i] = *(const u32x4*)(VTp + (size_t)r * SEQ + s_);                             \
        }                                                                                      \
    }
#define ATT_LSTORE(BUF)                                                                        \
    {                                                                                          \
        char* D_ = smem + (BUF) * ASTAGE;                                                      \
        _Pragma("unroll") for (int i = 0; i < KN; ++i) { const int id = tid + NTHR * i, row = id / KCH, ch = id % KCH; *(u32x4*)(D_ + row * KROWB + ch * 16) = kreg[i]; } \
        _Pragma("unroll") for (int i = 0; i < VN; ++i) { const int id = tid + NTHR * i, r = id >> 4, ch = id & 15; *(u32x4*)(D_ + 128 * KROWB + r * VROWB + ch * 16) = vreg[i]; } \
    }
    int kt0 = kbeg;
    if (SW) { while (kt0 + 127 < 0) kt0 += 128; }
    ATT_GLOAD(kt0)
    __syncthreads();
    ATT_LSTORE(0)
    if (kt0 + 128 < kend) ATT_GLOAD(kt0 + 128)
    __syncthreads();
    int cur = 0;
    for (; kt0 < kend; kt0 += 128) {
        const char* St = smem + cur * ASTAGE;
#pragma unroll 1
        for (int sub = 0; sub < 4; ++sub) {
            const int ks0 = kt0 + 32 * sub;
            if (ks0 > qw + 31) break;
            if (SW && (ks0 + 31 < qw - 127 || ks0 + 31 < 0)) continue;
            attn_sub<KROWB, VROWB, DV, SW>(O, m, lsum, qf, St + kw_off + sub * 32 * KROWB, St + vw_off + sub * 64, ks0, qw, qpos, g, slope2);
        }
        if (kt0 + 128 < kend) {
            ATT_LSTORE(cur ^ 1)
            if (kt0 + 256 < kend) ATT_GLOAD(kt0 + 256)
        }
        __syncthreads();
        cur ^= 1;
    }
#undef ATT_GLOAD
#undef ATT_LSTORE
    const float lt = sum_halves(lsum);
    if (!SW) {
        __syncthreads();
        char* X = smem + (wave >> 1) * 16384;
        const float sc = (map ? lam : 1.0f) / lt;
#pragma unroll
        for (int b = 0; b < NB; ++b)
#pragma unroll
            for (int r = 0; r < 16; ++r) O[b][r] *= sc;
        if (map) {
#pragma unroll
            for (int b = 0; b < NB; ++b)
#pragma unroll
                for (int j = 0; j < 4; ++j)
                    *(f32x4*)(X + ((b * 4 + j) * 64 + lane) * 16) = (f32x4){O[b][4 * j + 0], O[b][4 * j + 1], O[b][4 * j + 2], O[b][4 * j + 3]};
        }
        __syncthreads();
        if (!map) {
            float ss = 0.f;
#pragma unroll
            for (int b = 0; b < NB; ++b)
#pragma unroll
                for (int j = 0; j < 4; ++j) {
                    const f32x4 ob = *(const f32x4*)(X + ((b * 4 + j) * 64 + lane) * 16);
#pragma unroll
                    for (int i = 0; i < 4; ++i) {
                        const float a = O[b][4 * j + i] - ob[i];
                        O[b][4 * j + i] = a;
                        ss += a * a;
                    }
                }
            ss = sum_halves(ss);
            const float rn = __builtin_amdgcn_rsqf(ss * (1.0f / DV) + EPS);
#pragma unroll
            for (int b = 0; b < NB; ++b)
#pragma unroll
                for (int j = 0; j < 4; ++j) {
                    const int dv = 32 * b + 8 * j + 4 * g;
                    *(u32x2*)(Yp + (size_t)qpos * ldy + dv) = (u32x2){pk_bf16(O[b][4 * j + 0] * rn, O[b][4 * j + 1] * rn),
                                                                      pk_bf16(O[b][4 * j + 2] * rn, O[b][4 * j + 3] * rn)};
                }
        }
    } else {
        const float inv0 = 1.0f / lt;
#pragma unroll
        for (int b = 0; b < NB; ++b)
#pragma unroll
            for (int j = 0; j < 4; ++j) {
                const int dv = 32 * b + 8 * j + 4 * g;
                *(u32x2*)(Yp + (size_t)qpos * ldy + dv) = (u32x2){pk_bf16(O[b][4 * j + 0] * inv0, O[b][4 * j + 1] * inv0),
                                                                  pk_bf16(O[b][4 * j + 2] * inv0, O[b][4 * j + 3] * inv0)};
            }
    }
}

__device__ void phase_attn(const Params& p, int l, float lam, float lam_init, char* smem, int* s_item) {
    const int tid = opaque_tid(), wave = __builtin_amdgcn_readfirstlane(tid >> 6);
    int* ctr = (int*)(p.ws + OFF_CTR) + l;
    const bf16_t* QKDA = (const bf16_t*)(p.ws + OFF_QKDA);
    const bf16_t* VTDA = (const bf16_t*)(p.ws + OFF_VTDA);
    const bf16_t* QSW = (const bf16_t*)(p.ws + OFF_QSW);
    const bf16_t* KSW = (const bf16_t*)(p.ws + OFF_KSW);
    const bf16_t* VTSW = (const bf16_t*)(p.ws + OFF_VTSW);
    bf16_t* Y = (bf16_t*)(p.ws + OFF_Y);
    const int xcd = blockIdx.x & 7, slot = blockIdx.x >> 3, nslots = gridDim.x >> 3;
    (void)ctr; (void)s_item;
    for (int r = 0; r < 2; ++r)
        for (int j = slot; j < 32; j += nslots) {
            const int qb = r ? 31 - j : j, bh = 2 * xcd + r, b = bh >> 2, h = bh & 3;
            const int q0 = qb * 128;
            const float slope2 = exp2f(-2.0f * (h + 1)) * LOG2E;
            __syncthreads();
            attn_item<2, 128, false>(QKDA + (size_t)b * SEQ * 1024 + h * 128, 1024, QKDA + (size_t)b * SEQ * 1024 + 512 + h * 128, 1024,
                                     VTDA + (size_t)(b * 4 + h) * 128 * SEQ, Y + (size_t)b * SEQ * 1024 + h * 128, 1024, q0 + 32 * (wave >> 1),
                                     wave & 1, 0, q0 + 128, slope2, 0.f, lam, smem);
        }
    for (int j = slot; j < 64; j += nslots) {
        const int b = xcd >> 1, kvh = xcd & 1;
        const int q0 = j * 64, qw = q0 + 32 * (wave >> 2), head = kvh * 4 + (wave & 3);
        const float slope2 = exp2f(-(float)(head + 1)) * LOG2E;
        const float sink2 = p.sinks[l * 8 + head] * LOG2E;
        __syncthreads();
        attn_item<1, 64, true>(QSW + (size_t)b * SEQ * 512 + head * 64, 512, KSW + (size_t)b * SEQ * 128 + kvh * 64, 128,
                               VTSW + (size_t)(b * 2 + kvh) * 64 * SEQ, Y + (size_t)b * SEQ * 1024 + 512 + head * 64, 1024, qw, 0, q0 - 128,
                               q0 + 64, slope2, sink2, 0.f, smem);
    }
}

__device__ void phase_branch(const Params& p, int l, char* smem) {
    const int tid = opaque_tid(), lane = tid & 63, wave = tid >> 6, wm = wave >> 2, wn = wave & 3, g = lane >> 5, q = lane & 31;
    const bf16_t* Y = (const bf16_t*)(p.ws + OFF_Y);
    const bf16_t* G = (const bf16_t*)(p.ws + OFF_GATES);
    bf16_t* MG = (bf16_t*)(p.ws + OFF_QKDA);
    const bf16_t* W1 = (const bf16_t*)(p.ws + OFF_WT_DA + l * SZ_WT_BR);
    const bf16_t* W2 = (const bf16_t*)(p.ws + OFF_WT_SW + l * SZ_WT_BR);
    for (int t = virt_block(); t < 64 * 4; t += gridDim.x) {
        int mt, nt;
        tile_order(t, 64, 4, mt, nt);
        const int m0 = mt * BM, n0 = nt * BN;
        int aoff[4], boff[4];
        stage_offsets(aoff, m0, 1024, tid);
        stage_offsets(boff, n0, 512, tid);
        f32x16 acc[4][2];
        zero_acc(acc);
        gemm_mainloop<false>(acc, Y, aoff, W1, boff, 512 / BK, smem, false);
#pragma unroll
        for (int mi = 0; mi < 4; ++mi) {
            const int tok = m0 + wm * 128 + 32 * mi + q;
#pragma unroll
            for (int ni = 0; ni < 2; ++ni)
#pragma unroll
                for (int j = 0; j < 4; ++j) {
                    const int n = n0 + wn * 64 + 32 * ni + 8 * j + 4 * g;
                    u32x2 g1 = *(const u32x2*)(G + (size_t)tok * 2048 + n);
                    u32x2 g2 = *(const u32x2*)(G + (size_t)tok * 2048 + 1024 + n);
                    acc[mi][ni][4 * j + 0] *= bf2f_lo(g1[0]) * __builtin_amdgcn_rcpf(bf2f_lo(g2[0]));
                    acc[mi][ni][4 * j + 1] *= bf2f_hi(g1[0]) * __builtin_amdgcn_rcpf(bf2f_hi(g2[0]));
                    acc[mi][ni][4 * j + 2] *= bf2f_lo(g1[1]) * __builtin_amdgcn_rcpf(bf2f_lo(g2[1]));
                    acc[mi][ni][4 * j + 3] *= bf2f_hi(g1[1]) * __builtin_amdgcn_rcpf(bf2f_hi(g2[1]));
                }
            __builtin_amdgcn_sched_barrier(0);
        }
        gemm_mainloop<false>(acc, Y + 512, aoff, W2, boff, 512 / BK, smem, false);
#pragma unroll
        for (int mi = 0; mi < 4; ++mi) {
            const int tok = m0 + wm * 128 + 32 * mi + q;
            u32x2 gv[2][4];
#pragma unroll
            for (int ni = 0; ni < 2; ++ni)
#pragma unroll
                for (int j = 0; j < 4; ++j) gv[ni][j] = *(const u32x2*)(G + (size_t)tok * 2048 + 1024 + n0 + wn * 64 + 32 * ni + 8 * j + 4 * g);
#pragma unroll
            for (int ni = 0; ni < 2; ++ni)
#pragma unroll
                for (int j = 0; j < 4; ++j) {
                    const int n = n0 + wn * 64 + 32 * ni + 8 * j + 4 * g;
                    const float v0 = acc[mi][ni][4 * j + 0] * bf2f_lo(gv[ni][j][0]);
                    const float v1 = acc[mi][ni][4 * j + 1] * bf2f_hi(gv[ni][j][0]);
                    const float v2 = acc[mi][ni][4 * j + 2] * bf2f_lo(gv[ni][j][1]);
                    const float v3 = acc[mi][ni][4 * j + 3] * bf2f_hi(gv[ni][j][1]);
                    *(u32x2*)(MG + (size_t)tok * 1024 + n) = (u32x2){pk_bf16(v0, v1), pk_bf16(v2, v3)};
                }
        }
    }
}

__device__ void phase_resid(const Params& p, const bf16_t* A, int lda, const bf16_t* WT, int K, const float* xold, float* ssq, char* smem) {
    const int tid = opaque_tid(), lane = tid & 63, wave = tid >> 6, wm = wave >> 2, wn = wave & 3, g = lane >> 5, q = lane & 31;
    bf16_t* XB = (bf16_t*)(p.ws + OFF_XB);
    for (int t = virt_block(); t < 64 * 4; t += gridDim.x) {
        int mt, nt;
        tile_order(t, 64, 4, mt, nt);
        const int m0 = mt * BM, n0 = nt * BN;
        int aoff[4], boff[4];
        stage_offsets(aoff, m0, lda, tid);
        stage_offsets(boff, n0, K, tid);
        f32x16 acc[4][2];
        zero_acc(acc);
        gemm_mainloop<true>(acc, A, aoff, WT, boff, K / BK, smem, false);
#pragma unroll
        for (int mi = 0; mi < 4; ++mi) {
            const int tok = m0 + wm * 128 + 32 * mi + q;
            float s = 0.f;
            f32x4 xo[2][4];
#pragma unroll
            for (int ni = 0; ni < 2; ++ni)
#pragma unroll
                for (int j = 0; j < 4; ++j) xo[ni][j] = *(const f32x4*)(xold + (size_t)tok * DM + n0 + wn * 64 + 32 * ni + 8 * j + 4 * g);
#pragma unroll
            for (int ni = 0; ni < 2; ++ni)
#pragma unroll
                for (int j = 0; j < 4; ++j) {
                    const int n = n0 + wn * 64 + 32 * ni + 8 * j + 4 * g;
                    f32x4 xn;
                    xn[0] = xo[ni][j][0] + acc[mi][ni][4 * j + 0]; xn[1] = xo[ni][j][1] + acc[mi][ni][4 * j + 1];
                    xn[2] = xo[ni][j][2] + acc[mi][ni][4 * j + 2]; xn[3] = xo[ni][j][3] + acc[mi][ni][4 * j + 3];
                    s += xn[0] * xn[0] + xn[1] * xn[1] + xn[2] * xn[2] + xn[3] * xn[3];
                    *(f32x4*)(p.out + (size_t)tok * DM + n) = xn;
                    *(u32x2*)(XB + (size_t)tok * DM + n) = (u32x2){pk_bf16(xn[0], xn[1]), pk_bf16(xn[2], xn[3])};
                }
            s = sum_halves(s);
            if (g == 0) ssq[(size_t)tok * 16 + nt * 4 + wn] = s;
        }
    }
}

constexpr int USTRB = 528;
__device__ void phase_up(const Params& p, int l, char* smem) {
    const int tid = opaque_tid(), lane = tid & 63, wave = tid >> 6, wm = wave >> 2, wn = wave & 3, g = lane >> 5, q = lane & 31;
    const bf16_t* XB = (const bf16_t*)(p.ws + OFF_XB);
    const bf16_t* WT = (const bf16_t*)(p.ws + OFF_WT_UP + l * SZ_WT_UP);
    const float* ssq = (const float*)(p.ws + OFF_SSQ_FFN);
    bf16_t* H = (bf16_t*)(p.ws + OFF_GATES);
    const float* cw = p.conv_w + (size_t)l * 3 * DFF2;
    const float* cb = p.conv_b + (size_t)l * DFF2;
    int tpar = 0;
    for (int t = virt_block(); t < 68 * 22; t += gridDim.x) {
        int mt, nt;
        tile_order(t, 68, 22, mt, nt);
        const int b = mt / 17, ti = mt % 17;
        const int pos0 = -2 + 254 * ti;
        const int n0 = nt * BN;
        int aoff[4], boff[4];
#pragma unroll
        for (int i = 0; i < 4; ++i) {
            int pos = pos0 + (tid >> 3) + 64 * i;
            pos = pos < 0 ? 0 : (pos > SEQ - 1 ? SEQ - 1 : pos);
            aoff[i] = (b * SEQ + pos) * DM + (tid & 7) * 8;
        }
        stage_offsets(boff, n0, DM, tid);
        f32x16 acc[4][2];
        zero_acc(acc);
        float* rstd_s = (float*)(smem + RSTD_OFF) + (tpar & 1) * 256;
        ++tpar;
        if (tid < 256) {
            int pos = pos0 + tid;
            const bool zero = pos < 0;
            pos = pos < 0 ? 0 : (pos > SEQ - 1 ? SEQ - 1 : pos);
            const float rs = __builtin_amdgcn_rsqf(row_ssq(ssq, b * SEQ + pos) * (1.0f / DM) + EPS);
            rstd_s[tid] = zero ? 0.f : rs;
        }
        gemm_mainloop<true>(acc, XB, aoff, WT, boff, DM / BK, smem, false);
#pragma unroll
        for (int mi = 0; mi < 4; ++mi) {
            const int rl = wm * 128 + 32 * mi + q;
            const float rs = rstd_s[rl];
#pragma unroll
            for (int ni = 0; ni < 2; ++ni)
#pragma unroll
                for (int j = 0; j < 4; ++j) {
                    const int nl = wn * 64 + 32 * ni + 8 * j + 4 * g;
                    *(u32x2*)(smem + rl * USTRB + nl * 2) = (u32x2){pk_bf16(acc[mi][ni][4 * j + 0] * rs, acc[mi][ni][4 * j + 1] * rs),
                                                                    pk_bf16(acc[mi][ni][4 * j + 2] * rs, acc[mi][ni][4 * j + 3] * rs)};
                }
        }
        __syncthreads();
        {
            const int j4 = (tid & 31) * 4, rb = tid >> 5;
            const int jg = nt * 128 + j4;
            f32x4 wg[3], wv[3], bg, bv;
#pragma unroll
            for (int i = 0; i < 3; ++i) { wg[i] = *(const f32x4*)(cw + i * DFF2 + jg); wv[i] = *(const f32x4*)(cw + i * DFF2 + DFF + jg); }
            bg = *(const f32x4*)(cb + jg);
            bv = *(const f32x4*)(cb + DFF + jg);
#pragma unroll 4
            for (int i = 0; i < 16; ++i) {
                const int r = rb + 16 * i;
                const int pos = pos0 + r;
                if (r >= 2 && pos < SEQ) {
                    f32x4 cg_ = bg, cv_ = bv;
#pragma unroll
                    for (int jj = 0; jj < 3; ++jj) {
                        const u32x2 ug = *(const u32x2*)(smem + (r - 2 + jj) * USTRB + j4 * 2);
                        const u32x2 uv = *(const u32x2*)(smem + (r - 2 + jj) * USTRB + 256 + j4 * 2);
                        cg_[0] += bf2f_lo(ug[0]) * wg[jj][0]; cg_[1] += bf2f_hi(ug[0]) * wg[jj][1];
                        cg_[2] += bf2f_lo(ug[1]) * wg[jj][2]; cg_[3] += bf2f_hi(ug[1]) * wg[jj][3];
                        cv_[0] += bf2f_lo(uv[0]) * wv[jj][0]; cv_[1] += bf2f_hi(uv[0]) * wv[jj][1];
                        cv_[2] += bf2f_lo(uv[1]) * wv[jj][2]; cv_[3] += bf2f_hi(uv[1]) * wv[jj][3];
                    }
                    float h0 = cg_[0] * fast_sigmoid(cg_[0]) * cv_[0], h1 = cg_[1] * fast_sigmoid(cg_[1]) * cv_[1],
                          h2 = cg_[2] * fast_sigmoid(cg_[2]) * cv_[2], h3 = cg_[3] * fast_sigmoid(cg_[3]) * cv_[3];
                    *(u32x2*)(H + (size_t)(b * SEQ + pos) * DFF + jg) = (u32x2){pk_bf16(h0, h1), pk_bf16(h2, h3)};
                }
            }
        }
    }
}

__device__ void phase_final(const Params& p) {
    const int tid = opaque_tid(), lane = tid & 63, wave = tid >> 6;
    const float* ssq = (const float*)(p.ws + OFF_SSQ_MIX);
    for (int row = blockIdx.x * 8 + wave; row < NTOK; row += gridDim.x * 8) {
        float* xr = p.out + (size_t)row * DM;
        const float rs = __builtin_amdgcn_rsqf(row_ssq(ssq, row) * (1.0f / DM) + EPS);
#pragma unroll
        for (int i = 0; i < 4; ++i) {
            f32x4 v = *(const f32x4*)(xr + i * 256 + lane * 4);
            f32x4 w = *(const f32x4*)(p.norm_final_w + i * 256 + lane * 4);
            v[0] *= rs * w[0]; v[1] *= rs * w[1]; v[2] *= rs * w[2]; v[3] *= rs * w[3];
            *(f32x4*)(xr + i * 256 + lane * 4) = v;
        }
    }
}

DEVI void grid_barrier(unsigned* bar, unsigned target) {
    asm volatile("s_waitcnt vmcnt(0)" ::: "memory");
    __syncthreads();
    if (threadIdx.x == 0) {
        __builtin_amdgcn_fence(__ATOMIC_RELEASE, "agent");
        __hip_atomic_fetch_add(bar, 1u, __ATOMIC_RELAXED, __HIP_MEMORY_SCOPE_AGENT);
        while (__hip_atomic_load(bar, __ATOMIC_RELAXED, __HIP_MEMORY_SCOPE_AGENT) < target) __builtin_amdgcn_s_sleep(1);
        __builtin_amdgcn_fence(__ATOMIC_ACQUIRE, "agent");
        asm volatile("s_waitcnt vmcnt(0)" ::: "memory");
    }
    __syncthreads();
}

__global__ void __launch_bounds__(NTHR) mega_kernel(Params p, int phase_lo, int phase_hi, int use_sync) {
    __shared__ __attribute__((aligned(16))) char smem[SMEM_BYTES];
    __shared__ int s_item;
    cg::grid_group grid = cg::this_grid();
    int ph = 0;
#define PHASE_BEGIN if (ph >= phase_lo && ph < phase_hi) {
    unsigned* bar = (unsigned*)(p.ws + OFF_CTR);
    unsigned bar_target = 0;
#define PHASE_END   if (use_sync) { if (ph == 0) grid.sync(); else { bar_target += gridDim.x; grid_barrier(bar, bar_target); } } } ++ph;
    PHASE_BEGIN phase_convert(p, smem); PHASE_END
    for (int l = 0; l < DEPTH; ++l) {
        const float lam_init = 0.8f - 0.6f * expf(-0.3f * (float)l);
        float d1 = 0.f, d2 = 0.f;
        for (int i = 0; i < 64; ++i) { d1 += p.lq1[l * 64 + i] * p.lk1[l * 64 + i]; d2 += p.lq2[l * 64 + i] * p.lk2[l * 64 + i]; }
        const float lam = expf(d1) - expf(d2) + lam_init;
        PHASE_BEGIN phase_inproj(p, l, smem); PHASE_END
        PHASE_BEGIN phase_attn(p, l, lam, lam_init, smem, &s_item); PHASE_END
        PHASE_BEGIN phase_branch(p, l, smem); PHASE_END
        PHASE_BEGIN phase_resid(p, (const bf16_t*)(p.ws + OFF_QKDA), 1024, (const bf16_t*)(p.ws + OFF_WT_MIX + l * SZ_WT_MIX), 1024,
                                l == 0 ? p.x : p.out, (float*)(p.ws + OFF_SSQ_FFN), smem); PHASE_END
        PHASE_BEGIN phase_up(p, l, smem); PHASE_END
        PHASE_BEGIN phase_resid(p, (const bf16_t*)(p.ws + OFF_GATES), DFF, (const bf16_t*)(p.ws + OFF_WT_DN + l * SZ_WT_DN), DFF, p.out,
                                (float*)(p.ws + OFF_SSQ_MIX), smem); PHASE_END
    }
    if (ph >= phase_lo && ph < phase_hi) phase_final(p);
}

extern "C" void kernel_launch(void* const* d_in, const int* in_sizes, int n_in, void* d_out, int out_size, void* d_ws, size_t ws_size,
                              hipStream_t stream) {
    static int grid_blocks = 0;
    if (!grid_blocks) {
        int dev = 0, cus = 0, per_cu = 0;
        hipGetDevice(&dev);
        hipDeviceGetAttribute(&cus, hipDeviceAttributeMultiprocessorCount, dev);
        hipOccupancyMaxActiveBlocksPerMultiprocessor(&per_cu, mega_kernel, NTHR, 0);
        if (per_cu > 1) per_cu = 1;
        if (per_cu < 1) per_cu = 1;
        grid_blocks = cus * per_cu;
    }
    Params p{};
    const float* const* in = (const float* const*)d_in;
    p.x = in[0]; p.norm_mix_w = in[1]; p.w_in = in[2]; p.lq1 = in[3]; p.lk1 = in[4]; p.lq2 = in[5]; p.lk2 = in[6];
    p.subln_w = in[7]; p.sinks = in[8]; p.w_br_da = in[9]; p.w_br_sw = in[10]; p.w_mix_out = in[11]; p.norm_ffn_w = in[12];
    p.w_up = in[13]; p.conv_w = in[14]; p.conv_b = in[15]; p.w_down = in[16]; p.norm_final_w = in[17];
    p.out = (float*)d_out;
    p.ws = (char*)d_ws;
    if (ws_size < WS_TOTAL) { fprintf(stderr, "workspace too small: %zu < %zu\n", ws_size, (size_t)WS_TOTAL); return; }
#ifndef MULTI_LAUNCH
#define MULTI_LAUNCH 0
#endif
#if MULTI_LAUNCH
    for (int ph = 0; ph < 2 + 6 * DEPTH; ++ph) mega_kernel<<<dim3(grid_blocks), dim3(NTHR), 0, stream>>>(p, ph, ph + 1, 0);
#else
    int lo = 0, hi = 1000, us = 1;
    void* args[] = {&p, &lo, &hi, &us};
    hipMemsetAsync((char*)d_ws + OFF_CTR, 0, 256, stream);
    hipError_t e = hipLaunchCooperativeKernel((void*)mega_kernel, dim3(grid_blocks), dim3(NTHR), args, 0, stream);
    if (e != hipSuccess) fprintf(stderr, "cooperative launch failed: %s (grid %d)\n", hipGetErrorString(e), grid_blocks);
#endif
}
```

```cpp
#include <hip/hip_runtime.h>
#include <hip/hip_cooperative_groups.h>
#include <cstdio>
namespace cg = cooperative_groups;

typedef unsigned short bf16_t;
typedef short bf16x8 __attribute__((ext_vector_type(8)));
typedef float f32x16 __attribute__((ext_vector_type(16)));
typedef float f32x4 __attribute__((ext_vector_type(4)));
typedef unsigned u32x4 __attribute__((ext_vector_type(4)));
typedef unsigned u32x2 __attribute__((ext_vector_type(2)));

#define DEVI __device__ __forceinline__

constexpr int DM = 1024, NTOK = 16384, SEQ = 4096, DEPTH = 4;
constexpr int INC = 4352, DFF = 2816, DFF2 = 5632;
constexpr float EPS = 1e-6f;
constexpr float LOG2E = 1.4426950408889634f;
constexpr float QSCALE = 0.125f * LOG2E;

constexpr size_t SZ_WT_IN = (size_t)INC * DM * 2, SZ_WT_BR = (size_t)DM * 512 * 2, SZ_WT_MIX = (size_t)DM * DM * 2,
                 SZ_WT_UP = (size_t)DFF2 * DM * 2, SZ_WT_DN = (size_t)DM * DFF * 2;
constexpr size_t OFF_WT_IN = 0;
constexpr size_t OFF_WT_DA = OFF_WT_IN + DEPTH * SZ_WT_IN;
constexpr size_t OFF_WT_SW = OFF_WT_DA + DEPTH * SZ_WT_BR;
constexpr size_t OFF_WT_MIX = OFF_WT_SW + DEPTH * SZ_WT_BR;
constexpr size_t OFF_WT_UP = OFF_WT_MIX + DEPTH * SZ_WT_MIX;
constexpr size_t OFF_WT_DN = OFF_WT_UP + DEPTH * SZ_WT_UP;
constexpr size_t OFF_XB = OFF_WT_DN + DEPTH * SZ_WT_DN;
constexpr size_t OFF_SSQ_MIX = OFF_XB + (size_t)NTOK * DM * 2;
constexpr size_t OFF_SSQ_FFN = OFF_SSQ_MIX + (size_t)NTOK * 16 * 4;
constexpr size_t OFF_CTR = OFF_SSQ_FFN + (size_t)NTOK * 16 * 4;
constexpr size_t OFF_QKDA = OFF_CTR + 256;
constexpr size_t OFF_VTDA = OFF_QKDA + (size_t)NTOK * 1024 * 2;
constexpr size_t OFF_QSW = OFF_VTDA + (size_t)NTOK * 512 * 2;
constexpr size_t OFF_KSW = OFF_QSW + (size_t)NTOK * 512 * 2;
constexpr size_t OFF_VTSW = OFF_KSW + (size_t)NTOK * 128 * 2;
constexpr size_t OFF_GATES = OFF_VTSW + (size_t)NTOK * 128 * 2;
constexpr size_t OFF_Y = OFF_GATES + (size_t)NTOK * 2048 * 2;
constexpr size_t WS_TOTAL = OFF_Y + (size_t)NTOK * 1024 * 2;

struct Params {
    const float *x, *norm_mix_w, *w_in, *lq1, *lk1, *lq2, *lk2, *subln_w, *sinks, *w_br_da, *w_br_sw, *w_mix_out,
        *norm_ffn_w, *w_up, *conv_w, *conv_b, *w_down, *norm_final_w;
    float* out;
    char* ws;
};

constexpr int NTHR = 512;
constexpr int RSTD_OFF = 147456;
constexpr int SMEM_BYTES = 147456 + 2048;

typedef __bf16 bf16v2 __attribute__((ext_vector_type(2)));
typedef float f32x2 __attribute__((ext_vector_type(2)));
DEVI unsigned pk_bf16(float lo, float hi) {
    bf16v2 r = __builtin_convertvector((f32x2){lo, hi}, bf16v2);
    return __builtin_bit_cast(unsigned, r);
}
DEVI float bf2f_lo(unsigned u) { return __uint_as_float(u << 16); }
DEVI float bf2f_hi(unsigned u) { return __uint_as_float(u & 0xffff0000u); }
DEVI float fast_sigmoid(float x) { return __builtin_amdgcn_rcpf(1.0f + __builtin_amdgcn_exp2f(-x * LOG2E)); }
DEVI float sum_halves(float v) {
    u32x2 r = __builtin_amdgcn_permlane32_swap(__float_as_uint(v), __float_as_uint(v), false, false);
    return __uint_as_float(r[0]) + __uint_as_float(r[1]);
}
DEVI float max_halves(float v) {
    u32x2 r = __builtin_amdgcn_permlane32_swap(__float_as_uint(v), __float_as_uint(v), false, false);
    return fmaxf(__uint_as_float(r[0]), __uint_as_float(r[1]));
}
DEVI float row_ssq(const float* __restrict__ ssq, int tok) {
    const f32x4 a = *(const f32x4*)(ssq + (size_t)tok * 16), b = *(const f32x4*)(ssq + (size_t)tok * 16 + 4),
                c = *(const f32x4*)(ssq + (size_t)tok * 16 + 8), d = *(const f32x4*)(ssq + (size_t)tok * 16 + 12);
    return ((a[0] + a[1]) + (a[2] + a[3])) + ((b[0] + b[1]) + (b[2] + b[3])) + ((c[0] + c[1]) + (c[2] + c[3])) + ((d[0] + d[1]) + (d[2] + d[3]));
}
DEVI int opaque_tid() { int t = threadIdx.x; asm volatile("" : "+v"(t)); return t; }

__device__ void convert_weights(const Params& p, char* smem, int l_lo, int l_hi, int vb, int nvb) {
    const int tid = opaque_tid();
    const int half = tid >> 8, ht = tid & 255;
    float* T = (float*)smem + half * (64 * 65);
    const int total = (l_hi - l_lo) * 3712;
    const int iters = (total + 2 * nvb - 1) / (2 * nvb);
    for (int it = 0; it < iters; ++it) {
        const int t = (it * nvb + vb) * 2 + half;
        const bool act = t < total;
        const int l = l_lo + (act ? t / 3712 : 0);
        int r = act ? t % 3712 : 0;
        const float* W;
        const float* sc = nullptr;
        bf16_t* D;
        int K, N, mode = 0, scmask = 0x7fffffff;
        float scmul = 1.0f;
        if (r < 1088) {
            W = p.w_in + (size_t)l * DM * INC; K = DM; N = INC; sc = p.norm_mix_w + l * DM;
            D = (bf16_t*)(p.ws + OFF_WT_IN + l * SZ_WT_IN);
        } else if ((r -= 1088) < 128) {
            W = p.w_br_da + (size_t)l * 512 * DM; K = 512; N = DM; D = (bf16_t*)(p.ws + OFF_WT_DA + l * SZ_WT_BR);
            sc = p.subln_w + l * 128; scmask = 127; scmul = 1.0f - (0.8f - 0.6f * expf(-0.3f * (float)l));
        } else if ((r -= 128) < 128) {
            W = p.w_br_sw + (size_t)l * 512 * DM; K = 512; N = DM; D = (bf16_t*)(p.ws + OFF_WT_SW + l * SZ_WT_BR);
        } else if ((r -= 128) < 256) {
            W = p.w_mix_out + (size_t)l * DM * DM; K = DM; N = DM; D = (bf16_t*)(p.ws + OFF_WT_MIX + l * SZ_WT_MIX);
        } else if ((r -= 256) < 1408) {
            W = p.w_up + (size_t)l * DM * DFF2; K = DM; N = DFF2; sc = p.norm_ffn_w + l * DM; mode = 1;
            D = (bf16_t*)(p.ws + OFF_WT_UP + l * SZ_WT_UP);
        } else {
            r -= 1408;
            W = p.w_down + (size_t)l * DFF * DM; K = DFF; N = DM; D = (bf16_t*)(p.ws + OFF_WT_DN + l * SZ_WT_DN);
        }
        const int ntn = N >> 6;
        const int k0 = (r / ntn) * 64, n0 = (r % ntn) * 64;
        __syncthreads();
        if (act) {
#pragma unroll
            for (int i = 0; i < 4; ++i) {
                const int kr = (ht >> 4) + 16 * i, c4 = (ht & 15) * 4;
                f32x4 v = *(const f32x4*)(W + (size_t)(k0 + kr) * N + n0 + c4);
                const float s_ = sc ? sc[(k0 + kr) & scmask] * scmul : 1.0f;
                T[kr * 65 + c4 + 0] = v[0] * s_; T[kr * 65 + c4 + 1] = v[1] * s_;
                T[kr * 65 + c4 + 2] = v[2] * s_; T[kr * 65 + c4 + 3] = v[3] * s_;
            }
        }
        __syncthreads();
        if (act) {
            const int nl = ht >> 2, kc = (ht & 3) * 16;
            int n = n0 + nl;
            if (mode == 1) n = (n < DFF) ? ((n >> 7) * 256 + (n & 127)) : (((n - DFF) >> 7) * 256 + 128 + ((n - DFF) & 127));
            unsigned o[8];
#pragma unroll
            for (int e = 0; e < 8; ++e) o[e] = pk_bf16(T[(kc + 2 * e) * 65 + nl], T[(kc + 2 * e + 1) * 65 + nl]);
            bf16_t* dst = D + (size_t)n * K + k0 + kc;
            *(u32x4*)dst = (u32x4){o[0], o[1], o[2], o[3]};
            *(u32x4*)(dst + 8) = (u32x4){o[4], o[5], o[6], o[7]};
        }
    }
}

__device__ void phase_convert(const Params& p, char* smem) {
    convert_weights(p, smem, 0, 1, blockIdx.x, gridDim.x);
    const int tid = opaque_tid();
    {
        const int lane = tid & 63, wave = tid >> 6;
        bf16_t* XB = (bf16_t*)(p.ws + OFF_XB);
        float* ssq = (float*)(p.ws + OFF_SSQ_MIX);
        for (int row = blockIdx.x * 8 + wave; row < NTOK; row += gridDim.x * 8) {
            const float* xr = p.x + (size_t)row * DM;
            float s = 0.f;
#pragma unroll
            for (int i = 0; i < 4; ++i) {
                f32x4 v = *(const f32x4*)(xr + i * 256 + lane * 4);
                s += v[0] * v[0] + v[1] * v[1] + v[2] * v[2] + v[3] * v[3];
                *(u32x2*)(XB + (size_t)row * DM + i * 256 + lane * 4) = (u32x2){pk_bf16(v[0], v[1]), pk_bf16(v[2], v[3])};
            }
#pragma unroll
            for (int o = 32; o >= 1; o >>= 1) s += __shfl_xor(s, o, 64);
            if (lane < 16) ssq[(size_t)row * 16 + lane] = (lane == 0) ? s : 0.f;
        }
    }
}

constexpr int BM = 256, BN = 256, BK = 64;
constexpr int TROWB = 144;
constexpr int TA = BM * TROWB;
constexpr int TSTAGE = (BM + BN) * TROWB;
template <bool SWAP, bool PIPE>
DEVI void gemm_compute(f32x16 (&acc)[4][2], const char* S, int a_rd, int b_rd) {
    if (PIPE) {
        bf16x8 af[2][4], bf[2][2];
#pragma unroll
        for (int mi = 0; mi < 4; ++mi) af[0][mi] = *(const bf16x8*)(S + a_rd + mi * 32 * TROWB);
#pragma unroll
        for (int ni = 0; ni < 2; ++ni) bf[0][ni] = *(const bf16x8*)(S + b_rd + ni * 32 * TROWB);
#pragma unroll
        for (int kk = 0; kk < 4; ++kk) {
            const int c = kk & 1, n = c ^ 1;
            if (kk < 3) {
#pragma unroll
                for (int mi = 0; mi < 4; ++mi) af[n][mi] = *(const bf16x8*)(S + a_rd + mi * 32 * TROWB + (kk + 1) * 32);
#pragma unroll
                for (int ni = 0; ni < 2; ++ni) bf[n][ni] = *(const bf16x8*)(S + b_rd + ni * 32 * TROWB + (kk + 1) * 32);
            }
            __builtin_amdgcn_sched_barrier(0);
#pragma unroll
            for (int mi = 0; mi < 4; ++mi)
#pragma unroll
                for (int ni = 0; ni < 2; ++ni) {
                    if (SWAP) acc[mi][ni] = __builtin_amdgcn_mfma_f32_32x32x16_bf16(af[c][mi], bf[c][ni], acc[mi][ni], 0, 0, 0);
                    else acc[mi][ni] = __builtin_amdgcn_mfma_f32_32x32x16_bf16(bf[c][ni], af[c][mi], acc[mi][ni], 0, 0, 0);
                }
            __builtin_amdgcn_sched_barrier(0);
        }
    } else {
#pragma unroll
        for (int kk = 0; kk < 4; ++kk) {
            if (kk == 2) __builtin_amdgcn_sched_barrier(0);
            bf16x8 af[4], bf[2];
#pragma unroll
            for (int mi = 0; mi < 4; ++mi) af[mi] = *(const bf16x8*)(S + a_rd + mi * 32 * TROWB + kk * 32);
#pragma unroll
            for (int ni = 0; ni < 2; ++ni) bf[ni] = *(const bf16x8*)(S + b_rd + ni * 32 * TROWB + kk * 32);
#pragma unroll
            for (int mi = 0; mi < 4; ++mi)
#pragma unroll
                for (int ni = 0; ni < 2; ++ni) {
                    if (SWAP) acc[mi][ni] = __builtin_amdgcn_mfma_f32_32x32x16_bf16(af[mi], bf[ni], acc[mi][ni], 0, 0, 0);
                    else acc[mi][ni] = __builtin_amdgcn_mfma_f32_32x32x16_bf16(bf[ni], af[mi], acc[mi][ni], 0, 0, 0);
                }
        }
    }
}
DEVI void stage_offsets(int (&off)[4], int row0, int ld, int tid) {
#pragma unroll
    for (int i = 0; i < 4; ++i) off[i] = (row0 + (tid >> 3) + 64 * i) * ld + (tid & 7) * 8;
}
template <bool PIPE>
DEVI void gemm_mainloop(f32x16 (&acc)[4][2], const bf16_t* __restrict__ A, const int (&aoff)[4], const bf16_t* __restrict__ B,
                        const int (&boff)[4], int nk, char* smem, bool swap) {
    const int tid = opaque_tid(), lane = tid & 63, wave = tid >> 6;
    const int wm = wave >> 2, wn = wave & 3;
    const int g = lane >> 5, q = lane & 31;
    const int st_off = (tid >> 3) * TROWB + (tid & 7) * 16;
    const int a_rd = (wm * 128 + q) * TROWB + g * 16;
    const int b_rd = TA + (wn * 64 + q) * TROWB + g * 16;
    u32x4 ra[4], rb[4];
#define GLOAD(KT)                                                                              \
    {                                                                                          \
        _Pragma("unroll") for (int i = 0; i < 4; ++i) ra[i] = *(const u32x4*)(A + aoff[i] + (KT) * BK); \
        _Pragma("unroll") for (int i = 0; i < 4; ++i) rb[i] = *(const u32x4*)(B + boff[i] + (KT) * BK); \
    }
#define LSTORE(BUF)                                                                            \
    {                                                                                          \
        char* D_ = smem + (BUF) * TSTAGE;                                                      \
        _Pragma("unroll") for (int i = 0; i < 4; ++i) *(u32x4*)(D_ + st_off + i * 64 * TROWB) = ra[i];      \
        _Pragma("unroll") for (int i = 0; i < 4; ++i) *(u32x4*)(D_ + TA + st_off + i * 64 * TROWB) = rb[i]; \
    }
    GLOAD(0)
    __syncthreads();
    LSTORE(0)
    GLOAD(nk > 1 ? 1 : 0)
    __syncthreads();
    for (int kt = 0; kt < nk; ++kt) {
        const int cur = kt & 1;
        LSTORE(cur ^ 1)
        const int kn = (kt + 2 < nk) ? kt + 2 : nk - 1;
        GLOAD(kn)
        __builtin_amdgcn_sched_barrier(0);
        if (swap) gemm_compute<true, PIPE>(acc, smem + cur * TSTAGE, a_rd, b_rd); else gemm_compute<false, PIPE>(acc, smem + cur * TSTAGE, a_rd, b_rd);
        __builtin_amdgcn_sched_barrier(0);
        __syncthreads();
    }
#undef GLOAD
#undef LSTORE
}

DEVI void zero_acc(f32x16 (&acc)[4][2]) {
#pragma unroll
    for (int mi = 0; mi < 4; ++mi)
#pragma unroll
        for (int ni = 0; ni < 2; ++ni)
#pragma unroll
            for (int r = 0; r < 16; ++r) acc[mi][ni][r] = 0.f;
}

DEVI int virt_block() { return (blockIdx.x & 7) * (gridDim.x >> 3) + (blockIdx.x >> 3); }
DEVI void tile_order(int t, int MT, int NT, int& mt, int& nt) {
    const int grp = t / (8 * NT);
    const int first = grp * 8;
    const int gsz = (MT - first) < 8 ? (MT - first) : 8;
    const int rem = t - grp * 8 * NT;
    mt = first + rem % gsz;
    nt = rem / gsz;
}

__device__ void phase_inproj(const Params& p, int l, char* smem) {
    const int tid = opaque_tid(), lane = tid & 63, wave = tid >> 6, wm = wave >> 2, wn = wave & 3, g = lane >> 5, q = lane & 31;
    const bf16_t* XB = (const bf16_t*)(p.ws + OFF_XB);
    const bf16_t* WT = (const bf16_t*)(p.ws + OFF_WT_IN + l * SZ_WT_IN);
    const float* ssq = (const float*)(p.ws + OFF_SSQ_MIX);
    int tpar = 0;
    for (int t = virt_block(); t < 64 * 17; t += gridDim.x) {
        int mt, nt;
        tile_order(t, 64, 17, mt, nt);
        const int m0 = mt * BM, n0 = nt * BN;
        int aoff[4], boff[4];
        stage_offsets(aoff, m0, DM, tid);
        stage_offsets(boff, n0, DM, tid);
        f32x16 acc[4][2];
        zero_acc(acc);
        float* rstd_s = (float*)(smem + RSTD_OFF) + (tpar & 1) * 256;
        ++tpar;
        if (tid < 256) rstd_s[tid] = __builtin_amdgcn_rsqf(row_ssq(ssq, m0 + tid) * (1.0f / DM) + EPS);
        const int cb = n0 + wn * 64;
        const bool isv = (cb >= 1024 && cb < 1536) || (cb >= 2176 && cb < 2304);
        gemm_mainloop<true>(acc, XB, aoff, WT, boff, DM / BK, smem, isv);
        if (!isv) {
            bf16_t* dst; int ld, coff; int mode;
            if (cb < 512) { dst = (bf16_t*)(p.ws + OFF_QKDA); ld = 1024; coff = cb; mode = 0; }
            else if (cb < 1024) { dst = (bf16_t*)(p.ws + OFF_QKDA); ld = 1024; coff = cb; mode = 1; }
            else if (cb < 2048) { dst = (bf16_t*)(p.ws + OFF_QSW); ld = 512; coff = cb - 1536; mode = 0; }
            else if (cb < 2176) { dst = (bf16_t*)(p.ws + OFF_KSW); ld = 128; coff = cb - 2048; mode = 1; }
            else { dst = (bf16_t*)(p.ws + OFF_GATES); ld = 2048; coff = cb - 2304; mode = 2; }
#pragma unroll
            for (int mi = 0; mi < 4; ++mi) {
                const int tok = m0 + wm * 128 + 32 * mi + q;
                float rs = rstd_s[wm * 128 + 32 * mi + q];
                if (mode == 0) rs *= QSCALE;
#pragma unroll
                for (int ni = 0; ni < 2; ++ni)
#pragma unroll
                    for (int j = 0; j < 4; ++j) {
                        float v0 = acc[mi][ni][4 * j + 0] * rs, v1 = acc[mi][ni][4 * j + 1] * rs, v2 = acc[mi][ni][4 * j + 2] * rs,
                              v3 = acc[mi][ni][4 * j + 3] * rs;
                        if (mode == 2) { v0 = fast_sigmoid(v0); v1 = fast_sigmoid(v1); v2 = fast_sigmoid(v2); v3 = fast_sigmoid(v3); }
                        const int nl = 32 * ni + 8 * j + 4 * g;
                        *(u32x2*)(dst + (size_t)tok * ld + coff + nl) = (u32x2){pk_bf16(v0, v1), pk_bf16(v2, v3)};
                    }
            }
        } else {
            bf16_t* dst; int rowbase;
            const int b = m0 >> 12, s0 = m0 & 4095;
            int rows_per_b;
            if (cb < 1536) { dst = (bf16_t*)(p.ws + OFF_VTDA); rowbase = cb - 1024; rows_per_b = 512; }
            else { dst = (bf16_t*)(p.ws + OFF_VTSW); rowbase = cb - 2176; rows_per_b = 128; }
#pragma unroll
            for (int mi = 0; mi < 4; ++mi)
#pragma unroll
                for (int j = 0; j < 4; ++j) {
                    const int sl = wm * 128 + 32 * mi + 8 * j + 4 * g;
                    const f32x4 rq = *(const f32x4*)(rstd_s + sl);
                    const float r0 = rq[0], r1 = rq[1], r2 = rq[2], r3 = rq[3];
#pragma unroll
                    for (int ni = 0; ni < 2; ++ni) {
                        const int nl = 32 * ni + q;
                        bf16_t* d = dst + ((size_t)(b * rows_per_b + rowbase + nl)) * SEQ + s0 + sl;
                        *(u32x2*)d = (u32x2){pk_bf16(acc[mi][ni][4 * j + 0] * r0, acc[mi][ni][4 * j + 1] * r1),
                                             pk_bf16(acc[mi][ni][4 * j + 2] * r2, acc[mi][ni][4 * j + 3] * r3)};
                    }
                }
        }
    }
    if (l + 1 < DEPTH) {
        const int ntile = 64 * 17, g_ = gridDim.x, busy = ntile % g_;
        const int vb = virt_block();
        if (busy > 0 && busy < g_) {
            if (vb >= busy) { __syncthreads(); convert_weights(p, smem, l + 1, l + 2, vb - busy, g_ - busy); }
        } else {
            __syncthreads();
            convert_weights(p, smem, l + 1, l + 2, vb, g_);
        }
    }
}

#define CJI(r) (16 * ((r) >> 3) + ((r) & 7))
template <int KROWB, int VROWB, int DV, bool SW>
DEVI void attn_sub(f32x16 (&O)[DV / 32], float& m, float& lsum, const bf16x8 (&qf)[4], const char* Ksub, const char* Vsub, int ks0, int qw,
                   int qpos, int g, float slope2) {
    constexpr int NB = DV / 32;
    const int relbase = ks0 + 8 * g - qpos;
    const float basef = slope2 * (float)relbase;
    const bool need_mask = SW || (ks0 + 31 > qw);
    bf16x8 kf[4], vf[2][NB];
#pragma unroll
    for (int kk = 0; kk < 4; ++kk) kf[kk] = *(const bf16x8*)(Ksub + kk * 32);
#pragma unroll
    for (int t = 0; t < 2; ++t)
#pragma unroll
        for (int b = 0; b < NB; ++b) vf[t][b] = *(const bf16x8*)(Vsub + b * 32 * VROWB + t * 32);
    __builtin_amdgcn_sched_barrier(0);
    f32x16 S;
#pragma unroll
    for (int r = 0; r < 16; ++r) S[r] = __builtin_fmaf(slope2, (float)CJI(r), basef);
#pragma unroll
    for (int kk = 0; kk < 4; ++kk) S = __builtin_amdgcn_mfma_f32_32x32x16_bf16(kf[kk], qf[kk], S, 0, 0, 0);
    if (need_mask) {
#pragma unroll
        for (int r = 0; r < 16; ++r) {
            const int rel = relbase + CJI(r);
            bool valid = rel <= 0;
            if (SW) valid = valid && (rel > -128) && (rel + qpos >= 0);
            S[r] = valid ? S[r] : -1e30f;
        }
    }
    float mx = S[0];
#pragma unroll
    for (int r = 1; r < 16; ++r) mx = fmaxf(mx, S[r]);
    mx = max_halves(mx);
    if (__builtin_amdgcn_ballot_w64(mx > m + 12.0f) != 0ull) {
        const float mn = fmaxf(m, mx);
        const float alpha = __builtin_amdgcn_exp2f(m - mn);
        m = mn;
        lsum *= alpha;
#pragma unroll
        for (int b = 0; b < NB; ++b)
#pragma unroll
            for (int r = 0; r < 16; ++r) O[b][r] *= alpha;
    }
    float ps = 0.f;
#pragma unroll
    for (int r = 0; r < 16; ++r) { S[r] = __builtin_amdgcn_exp2f(S[r] - m); ps += S[r]; }
    lsum += ps;
    bf16x8 P[2];
#pragma unroll
    for (int t = 0; t < 2; ++t) {
        u32x4 pk = (u32x4){pk_bf16(S[8 * t + 0], S[8 * t + 1]), pk_bf16(S[8 * t + 2], S[8 * t + 3]), pk_bf16(S[8 * t + 4], S[8 * t + 5]),
                           pk_bf16(S[8 * t + 6], S[8 * t + 7])};
        P[t] = __builtin_bit_cast(bf16x8, pk);
    }
#pragma unroll
    for (int t = 0; t < 2; ++t)
#pragma unroll
        for (int b = 0; b < NB; ++b) O[b] = __builtin_amdgcn_mfma_f32_32x32x16_bf16(vf[t][b], P[t], O[b], 0, 0, 0);
}

template <int KW, int DV, bool SW>
DEVI void attn_item(const bf16_t* __restrict__ Qp, int ldq, const bf16_t* __restrict__ Kp, int ldk, const bf16_t* __restrict__ VTp,
                    bf16_t* __restrict__ Yp, int ldy, int qw, int map, int kbeg, int kend, float slope2, float sink2, float lam, char* smem) {
    constexpr int KROWB = KW * 128 + 16;
    constexpr int VROWB = 272;
    constexpr int KCH = KW * 8;
    constexpr int NB = DV / 32;
    constexpr int KN = (128 * KCH) / NTHR, VN = (DV * 16) / NTHR;
    constexpr int ASTAGE = 128 * KROWB + DV * VROWB;
    const int tid = opaque_tid(), lane = tid & 63, q = lane & 31, g = lane >> 5, wave = __builtin_amdgcn_readfirstlane(tid >> 6);
    const int qpos = qw + q;
    bf16x8 qf[4];
#pragma unroll
    for (int kk = 0; kk < 4; ++kk) qf[kk] = *(const bf16x8*)(Qp + (size_t)qpos * ldq + map * 64 + kk * 16 + g * 8);
    f32x16 O[NB];
#pragma unroll
    for (int b = 0; b < NB; ++b)
#pragma unroll
        for (int r = 0; r < 16; ++r) O[b][r] = 0.f;
    float m = SW ? sink2 : -1e30f, lsum = (SW && g == 0) ? 1.f : 0.f;
    const int pr = (q & 0x13) | ((q & 4) << 1) | ((q & 8) >> 1);
    const int kw_off = pr * KROWB + g * 16 + map * 128;
    const int vw_off = 128 * KROWB + q * VROWB + g * 16;
    u32x4 kreg[KN], vreg[VN];
#define ATT_GLOAD(KT0)                                                                         \
    {                                                                                          \
        _Pragma("unroll") for (int i = 0; i < KN; ++i) {                                       \
            const int id = tid + NTHR * i, row = id / KCH, ch = id % KCH;                      \
            int tok = (KT0) + row;                                                             \
            tok = tok < 0 ? 0 : (tok > SEQ - 1 ? SEQ - 1 : tok);                               \
            kreg[i] = *(const u32x4*)(Kp + (size_t)tok * ldk + ch * 8);                        \
        }                                                                                      \
        _Pragma("unroll") for (int i = 0; i < VN; ++i) {                                       \
            const int id = tid + NTHR * i, r = id >> 4, ch = id & 15;                          \
            int s_ = (KT0) + ch * 8;                                                           \
            s_ = s_ < 0 ? 0 : (s_ > SEQ - 8 ? SEQ - 8 : s_);                                   \
            vreg[i] = *(const u32x4*)(VTp + (size_t)r * SEQ + s_);                             \
        }                                                                                      \
    }
#define ATT_LSTORE(BUF)                                                                        \
    {                                                                                          \
        char* D_ = smem + (BUF) * ASTAGE;                                                      \
        _Pragma("unroll") for (int i = 0; i < KN; ++i) { const int id = tid + NTHR * i, row = id / KCH, ch = id % KCH; *(u32x4*)(D_ + row * KROWB + ch * 16) = kreg[i]; } \
        _Pragma("unroll") for (int i = 0; i < VN; ++i) { const int id = tid + NTHR * i, r = id >> 4, ch = id & 15; *(u32x4*)(D_ + 128 * KROWB + r * VROWB + ch * 16) = vreg[i]; } \
    }
    int kt0 = kbeg;
    if (SW) { while (kt0 + 127 < 0) kt0 += 128; }
    ATT_GLOAD(kt0)
    __syncthreads();
    ATT_LSTORE(0)
    if (kt0 + 128 < kend) ATT_GLOAD(kt0 + 128)
    __syncthreads();
    int cur = 0;
    for (; kt0 < kend; kt0 += 128) {
        const char* St = smem + cur * ASTAGE;
#pragma unroll 1
        for (int sub = 0; sub < 4; ++sub) {
            const int ks0 = kt0 + 32 * sub;
            if (ks0 > qw + 31) break;
            if (SW && (ks0 + 31 < qw - 127 || ks0 + 31 < 0)) continue;
            attn_sub<KROWB, VROWB, DV, SW>(O, m, lsum, qf, St + kw_off + sub * 32 * KROWB, St + vw_off + sub * 64, ks0, qw, qpos, g, slope2);
        }
        if (kt0 + 128 < kend) {
            ATT_LSTORE(cur ^ 1)
            if (kt0 + 256 < kend) ATT_GLOAD(kt0 + 256)
        }
        __syncthreads();
        cur ^= 1;
    }
#undef ATT_GLOAD
#undef ATT_LSTORE
    const float lt = sum_halves(lsum);
    if (!SW) {
        __syncthreads();
        char* X = smem + (wave >> 1) * 16384;
        const float sc = (map ? lam : 1.0f) / lt;
#pragma unroll
        for (int b = 0; b < NB; ++b)
#pragma unroll
            for (int r = 0; r < 16; ++r) O[b][r] *= sc;
        if (map) {
#pragma unroll
            for (int b = 0; b < NB; ++b)
#pragma unroll
                for (int j = 0; j < 4; ++j)
                    *(f32x4*)(X + ((b * 4 + j) * 64 + lane) * 16) = (f32x4){O[b][4 * j + 0], O[b][4 * j + 1], O[b][4 * j + 2], O[b][4 * j + 3]};
        }
        __syncthreads();
        if (!map) {
            float ss = 0.f;
#pragma unroll
            for (int b = 0; b < NB; ++b)
#pragma unroll
                for (int j = 0; j < 4; ++j) {
                    const f32x4 ob = *(const f32x4*)(X + ((b * 4 + j) * 64 + lane) * 16);
#pragma unroll
                    for (int i = 0; i < 4; ++i) {
                        const float a = O[b][4 * j + i] - ob[i];
                        O[b][4 * j + i] = a;
                        ss += a * a;
                    }
                }
            ss = sum_halves(ss);
            const float rn = __builtin_amdgcn_rsqf(ss * (1.0f / DV) + EPS);
#pragma unroll
            for (int b = 0; b < NB; ++b)
#pragma unroll
                for (int j = 0; j < 4; ++j) {
                    const int dv = 32 * b + 8 * j + 4 * g;
                    *(u32x2*)(Yp + (size_t)qpos * ldy + dv) = (u32x2){pk_bf16(O[b][4 * j + 0] * rn, O[b][4 * j + 1] * rn),
                                                                      pk_bf16(O[b][4 * j + 2] * rn, O[b][4 * j + 3] * rn)};
                }
        }
    } else {
        const float inv0 = 1.0f / lt;
#pragma unroll
        for (int b = 0; b < NB; ++b)
#pragma unroll
            for (int j = 0; j < 4; ++j) {
                const int dv = 32 * b + 8 * j + 4 * g;
                *(u32x2*)(Yp + (size_t)qpos * ldy + dv) = (u32x2){pk_bf16(O[b][4 * j + 0] * inv0, O[b][4 * j + 1] * inv0),
                                                                  pk_bf16(O[b][4 * j + 2] * inv0, O[b][4 * j + 3] * inv0)};
            }
    }
}

__device__ void phase_attn(const Params& p, int l, float lam, float lam_init, char* smem, int* s_item) {
    const int tid = opaque_tid(), wave = __builtin_amdgcn_readfirstlane(tid >> 6);
    int* ctr = (int*)(p.ws + OFF_CTR) + l;
    const bf16_t* QKDA = (const bf16_t*)(p.ws + OFF_QKDA);
    const bf16_t* VTDA = (const bf16_t*)(p.ws + OFF_VTDA);
    const bf16_t* QSW = (const bf16_t*)(p.ws + OFF_QSW);
    const bf16_t* KSW = (const bf16_t*)(p.ws + OFF_KSW);
    const bf16_t* VTSW = (const bf16_t*)(p.ws + OFF_VTSW);
    bf16_t* Y = (bf16_t*)(p.ws + OFF_Y);
    const int xcd = blockIdx.x & 7, slot = blockIdx.x >> 3, nslots = gridDim.x >> 3;
    (void)ctr; (void)s_item;
    for (int r = 0; r < 2; ++r)
        for (int j = slot; j < 32; j += nslots) {
            const int qb = r ? 31 - j : j, bh = 2 * xcd + r, b = bh >> 2, h = bh & 3;
            const int q0 = qb * 128;
            const float slope2 = exp2f(-2.0f * (h + 1)) * LOG2E;
            __syncthreads();
            attn_item<2, 128, false>(QKDA + (size_t)b * SEQ * 1024 + h * 128, 1024, QKDA + (size_t)b * SEQ * 1024 + 512 + h * 128, 1024,
                                     VTDA + (size_t)(b * 4 + h) * 128 * SEQ, Y + (size_t)b * SEQ * 1024 + h * 128, 1024, q0 + 32 * (wave >> 1),
                                     wave & 1, 0, q0 + 128, slope2, 0.f, lam, smem);
        }
    for (int j = slot; j < 64; j += nslots) {
        const int b = xcd >> 1, kvh = xcd & 1;
        const int q0 = j * 64, qw = q0 + 32 * (wave >> 2), head = kvh * 4 + (wave & 3);
        const float slope2 = exp2f(-(float)(head + 1)) * LOG2E;
        const float sink2 = p.sinks[l * 8 + head] * LOG2E;
        __syncthreads();
        attn_item<1, 64, true>(QSW + (size_t)b * SEQ * 512 + head * 64, 512, KSW + (size_t)b * SEQ * 128 + kvh * 64, 128,
                               VTSW + (size_t)(b * 2 + kvh) * 64 * SEQ, Y + (size_t)b * SEQ * 1024 + 512 + head * 64, 1024, qw, 0, q0 - 128,
                               q0 + 64, slope2, sink2, 0.f, smem);
    }
}

__device__ void phase_branch(const Params& p, int l, char* smem) {
    const int tid = opaque_tid(), lane = tid & 63, wave = tid >> 6, wm = wave >> 2, wn = wave & 3, g = lane >> 5, q = lane & 31;
    const bf16_t* Y = (const bf16_t*)(p.ws + OFF_Y);
    const bf16_t* G = (const bf16_t*)(p.ws + OFF_GATES);
    bf16_t* MG = (bf16_t*)(p.ws + OFF_QKDA);
    const bf16_t* W1 = (const bf16_t*)(p.ws + OFF_WT_DA + l * SZ_WT_BR);
    const bf16_t* W2 = (const bf16_t*)(p.ws + OFF_WT_SW + l * SZ_WT_BR);
    for (int t = virt_block(); t < 64 * 4; t += gridDim.x) {
        int mt, nt;
        tile_order(t, 64, 4, mt, nt);
        const int m0 = mt * BM, n0 = nt * BN;
        int aoff[4], boff[4];
        stage_offsets(aoff, m0, 1024, tid);
        stage_offsets(boff, n0, 512, tid);
        f32x16 acc[4][2];
        zero_acc(acc);
        gemm_mainloop<false>(acc, Y, aoff, W1, boff, 512 / BK, smem, false);
#pragma unroll
        for (int mi = 0; mi < 4; ++mi) {
            const int tok = m0 + wm * 128 + 32 * mi + q;
#pragma unroll
            for (int ni = 0; ni < 2; ++ni)
#pragma unroll
                for (int j = 0; j < 4; ++j) {
                    const int n = n0 + wn * 64 + 32 * ni + 8 * j + 4 * g;
                    u32x2 g1 = *(const u32x2*)(G + (size_t)tok * 2048 + n);
                    u32x2 g2 = *(const u32x2*)(G + (size_t)tok * 2048 + 1024 + n);
                    acc[mi][ni][4 * j + 0] *= bf2f_lo(g1[0]) * __builtin_amdgcn_rcpf(bf2f_lo(g2[0]));
                    acc[mi][ni][4 * j + 1] *= bf2f_hi(g1[0]) * __builtin_amdgcn_rcpf(bf2f_hi(g2[0]));
                    acc[mi][ni][4 * j + 2] *= bf2f_lo(g1[1]) * __builtin_amdgcn_rcpf(bf2f_lo(g2[1]));
                    acc[mi][ni][4 * j + 3] *= bf2f_hi(g1[1]) * __builtin_amdgcn_rcpf(bf2f_hi(g2[1]));
                }
            __builtin_amdgcn_sched_barrier(0);
        }
        gemm_mainloop<false>(acc, Y + 512, aoff, W2, boff, 512 / BK, smem, false);
#pragma unroll
        for (int mi = 0; mi < 4; ++mi) {
            const int tok = m0 + wm * 128 + 32 * mi + q;
            u32x2 gv[2][4];
#pragma unroll
            for (int ni = 0; ni < 2; ++ni)
#pragma unroll
                for (int j = 0; j < 4; ++j) gv[ni][j] = *(const u32x2*)(G + (size_t)tok * 2048 + 1024 + n0 + wn * 64 + 32 * ni + 8 * j + 4 * g);
#pragma unroll
            for (int ni = 0; ni < 2; ++ni)
#pragma unroll
                for (int j = 0; j < 4; ++j) {
                    const int n = n0 + wn * 64 + 32 * ni + 8 * j + 4 * g;
                    const float v0 = acc[mi][ni][4 * j + 0] * bf2f_lo(gv[ni][j][0]);
                    const float v1 = acc[mi][ni][4 * j + 1] * bf2f_hi(gv[ni][j][0]);
                    const float v2 = acc[mi][ni][4 * j + 2] * bf2f_lo(gv[ni][j][1]);
                    const float v3 = acc[mi][ni][4 * j + 3] * bf2f_hi(gv[ni][j][1]);
                    *(u32x2*)(MG + (size_t)tok * 1024 + n) = (u32x2){pk_bf16(v0, v1), pk_bf16(v2, v3)};
                }
        }
    }
}

__device__ void phase_resid(const Params& p, const bf16_t* A, int lda, const bf16_t* WT, int K, const float* xold, float* ssq, char* smem) {
    const int tid = opaque_tid(), lane = tid & 63, wave = tid >> 6, wm = wave >> 2, wn = wave & 3, g = lane >> 5, q = lane & 31;
    bf16_t* XB = (bf16_t*)(p.ws + OFF_XB);
    for (int t = virt_block(); t < 64 * 4; t += gridDim.x) {
        int mt, nt;
        tile_order(t, 64, 4, mt, nt);
        const int m0 = mt * BM, n0 = nt * BN;
        int aoff[4], boff[4];
        stage_offsets(aoff, m0, lda, tid);
        stage_offsets(boff, n0, K, tid);
        f32x16 acc[4][2];
        zero_acc(acc);
        gemm_mainloop<true>(acc, A, aoff, WT, boff, K / BK, smem, false);
#pragma unroll
        for (int mi = 0; mi < 4; ++mi) {
            const int tok = m0 + wm * 128 + 32 * mi + q;
            float s = 0.f;
            f32x4 xo[2][4];
            if (xold) {
#pragma unroll
                for (int ni = 0; ni < 2; ++ni)
#pragma unroll
                    for (int j = 0; j < 4; ++j) xo[ni][j] = *(const f32x4*)(xold + (size_t)tok * DM + n0 + wn * 64 + 32 * ni + 8 * j + 4 * g);
            } else {
#pragma unroll
                for (int ni = 0; ni < 2; ++ni)
#pragma unroll
                    for (int j = 0; j < 4; ++j) {
                        const u32x2 xv = *(const u32x2*)(XB + (size_t)tok * DM + n0 + wn * 64 + 32 * ni + 8 * j + 4 * g);
                        xo[ni][j] = (f32x4){bf2f_lo(xv[0]), bf2f_hi(xv[0]), bf2f_lo(xv[1]), bf2f_hi(xv[1])};
                    }
            }
#pragma unroll
            for (int ni = 0; ni < 2; ++ni)
#pragma unroll
                for (int j = 0; j < 4; ++j) {
                    const int n = n0 + wn * 64 + 32 * ni + 8 * j + 4 * g;
                    f32x4 xn;
                    xn[0] = xo[ni][j][0] + acc[mi][ni][4 * j + 0]; xn[1] = xo[ni][j][1] + acc[mi][ni][4 * j + 1];
                    xn[2] = xo[ni][j][2] + acc[mi][ni][4 * j + 2]; xn[3] = xo[ni][j][3] + acc[mi][ni][4 * j + 3];
                    s += xn[0] * xn[0] + xn[1] * xn[1] + xn[2] * xn[2] + xn[3] * xn[3];
                    *(u32x2*)(XB + (size_t)tok * DM + n) = (u32x2){pk_bf16(xn[0], xn[1]), pk_bf16(xn[2], xn[3])};
                }
            s = sum_halves(s);
            if (g == 0) ssq[(size_t)tok * 16 + nt * 4 + wn] = s;
        }
    }
}

constexpr int USTRB = 528;
__device__ void phase_up(const Params& p, int l, char* smem) {
    const int tid = opaque_tid(), lane = tid & 63, wave = tid >> 6, wm = wave >> 2, wn = wave & 3, g = lane >> 5, q = lane & 31;
    const bf16_t* XB = (const bf16_t*)(p.ws + OFF_XB);
    const bf16_t* WT = (const bf16_t*)(p.ws + OFF_WT_UP + l * SZ_WT_UP);
    const float* ssq = (const float*)(p.ws + OFF_SSQ_FFN);
    bf16_t* H = (bf16_t*)(p.ws + OFF_GATES);
    const float* cw = p.conv_w + (size_t)l * 3 * DFF2;
    const float* cb = p.conv_b + (size_t)l * DFF2;
    int tpar = 0;
    for (int t = virt_block(); t < 68 * 22; t += gridDim.x) {
        int mt, nt;
        tile_order(t, 68, 22, mt, nt);
        const int b = mt / 17, ti = mt % 17;
        const int pos0 = -2 + 254 * ti;
        const int n0 = nt * BN;
        int aoff[4], boff[4];
#pragma unroll
        for (int i = 0; i < 4; ++i) {
            int pos = pos0 + (tid >> 3) + 64 * i;
            pos = pos < 0 ? 0 : (pos > SEQ - 1 ? SEQ - 1 : pos);
            aoff[i] = (b * SEQ + pos) * DM + (tid & 7) * 8;
        }
        stage_offsets(boff, n0, DM, tid);
        f32x16 acc[4][2];
        zero_acc(acc);
        float* rstd_s = (float*)(smem + RSTD_OFF) + (tpar & 1) * 256;
        ++tpar;
        if (tid < 256) {
            int pos = pos0 + tid;
            const bool zero = pos < 0;
            pos = pos < 0 ? 0 : (pos > SEQ - 1 ? SEQ - 1 : pos);
            const float rs = __builtin_amdgcn_rsqf(row_ssq(ssq, b * SEQ + pos) * (1.0f / DM) + EPS);
            rstd_s[tid] = zero ? 0.f : rs;
        }
        gemm_mainloop<true>(acc, XB, aoff, WT, boff, DM / BK, smem, false);
#pragma unroll
        for (int mi = 0; mi < 4; ++mi) {
            const int rl = wm * 128 + 32 * mi + q;
            const float rs = rstd_s[rl];
#pragma unroll
            for (int ni = 0; ni < 2; ++ni)
#pragma unroll
                for (int j = 0; j < 4; ++j) {
                    const int nl = wn * 64 + 32 * ni + 8 * j + 4 * g;
                    *(u32x2*)(smem + rl * USTRB + nl * 2) = (u32x2){pk_bf16(acc[mi][ni][4 * j + 0] * rs, acc[mi][ni][4 * j + 1] * rs),
                                                                    pk_bf16(acc[mi][ni][4 * j + 2] * rs, acc[mi][ni][4 * j + 3] * rs)};
                }
        }
        __syncthreads();
        {
            const int j4 = (tid & 31) * 4, rb = tid >> 5;
            const int jg = nt * 128 + j4;
            f32x4 wg[3], wv[3], bg, bv;
#pragma unroll
            for (int i = 0; i < 3; ++i) { wg[i] = *(const f32x4*)(cw + i * DFF2 + jg); wv[i] = *(const f32x4*)(cw + i * DFF2 + DFF + jg); }
            bg = *(const f32x4*)(cb + jg);
            bv = *(const f32x4*)(cb + DFF + jg);
#pragma unroll 4
            for (int i = 0; i < 16; ++i) {
                const int r = rb + 16 * i;
                const int pos = pos0 + r;
                if (r >= 2 && pos < SEQ) {
                    f32x4 cg_ = bg, cv_ = bv;
#pragma unroll
                    for (int jj = 0; jj < 3; ++jj) {
                        const u32x2 ug = *(const u32x2*)(smem + (r - 2 + jj) * USTRB + j4 * 2);
                        const u32x2 uv = *(const u32x2*)(smem + (r - 2 + jj) * USTRB + 256 + j4 * 2);
                        cg_[0] += bf2f_lo(ug[0]) * wg[jj][0]; cg_[1] += bf2f_hi(ug[0]) * wg[jj][1];
                        cg_[2] += bf2f_lo(ug[1]) * wg[jj][2]; cg_[3] += bf2f_hi(ug[1]) * wg[jj][3];
                        cv_[0] += bf2f_lo(uv[0]) * wv[jj][0]; cv_[1] += bf2f_hi(uv[0]) * wv[jj][1];
                        cv_[2] += bf2f_lo(uv[1]) * wv[jj][2]; cv_[3] += bf2f_hi(uv[1]) * wv[jj][3];
                    }
                    float h0 = cg_[0] * fast_sigmoid(cg_[0]) * cv_[0], h1 = cg_[1] * fast_sigmoid(cg_[1]) * cv_[1],
                          h2 = cg_[2] * fast_sigmoid(cg_[2]) * cv_[2], h3 = cg_[3] * fast_sigmoid(cg_[3]) * cv_[3];
                    *(u32x2*)(H + (size_t)(b * SEQ + pos) * DFF + jg) = (u32x2){pk_bf16(h0, h1), pk_bf16(h2, h3)};
                }
            }
        }
    }
}

__device__ void phase_final(const Params& p) {
    const int tid = opaque_tid(), lane = tid & 63, wave = tid >> 6;
    const float* ssq = (const float*)(p.ws + OFF_SSQ_MIX);
    const bf16_t* XB = (const bf16_t*)(p.ws + OFF_XB);
    for (int row = blockIdx.x * 8 + wave; row < NTOK; row += gridDim.x * 8) {
        float* xr = p.out + (size_t)row * DM;
        const float rs = __builtin_amdgcn_rsqf(row_ssq(ssq, row) * (1.0f / DM) + EPS);
#pragma unroll
        for (int i = 0; i < 4; ++i) {
            const u32x2 xv = *(const u32x2*)(XB + (size_t)row * DM + i * 256 + lane * 4);
            f32x4 w = *(const f32x4*)(p.norm_final_w + i * 256 + lane * 4);
            f32x4 v;
            v[0] = bf2f_lo(xv[0]) * rs * w[0]; v[1] = bf2f_hi(xv[0]) * rs * w[1]; v[2] = bf2f_lo(xv[1]) * rs * w[2]; v[3] = bf2f_hi(xv[1]) * rs * w[3];
            *(f32x4*)(xr + i * 256 + lane * 4) = v;
        }
    }
}

DEVI void grid_barrier(unsigned* bar, unsigned target) {
    asm volatile("s_waitcnt vmcnt(0)" ::: "memory");
    __syncthreads();
    if (threadIdx.x == 0) {
        __builtin_amdgcn_fence(__ATOMIC_RELEASE, "agent");
        __hip_atomic_fetch_add(bar, 1u, __ATOMIC_RELAXED, __HIP_MEMORY_SCOPE_AGENT);
        while (__hip_atomic_load(bar, __ATOMIC_RELAXED, __HIP_MEMORY_SCOPE_AGENT) < target) __builtin_amdgcn_s_sleep(1);
        __builtin_amdgcn_fence(__ATOMIC_ACQUIRE, "agent");
        asm volatile("s_waitcnt vmcnt(0)" ::: "memory");
    }
    __syncthreads();
}

__global__ void __launch_bounds__(NTHR) mega_kernel(Params p, int phase_lo, int phase_hi, int use_sync) {
    __shared__ __attribute__((aligned(16))) char smem[SMEM_BYTES];
    __shared__ int s_item;
    cg::grid_group grid = cg::this_grid();
    int ph = 0;
#define PHASE_BEGIN if (ph >= phase_lo && ph < phase_hi) {
    unsigned* bar = (unsigned*)(p.ws + OFF_CTR);
    unsigned bar_target = 0;
#define PHASE_END   if (use_sync) { if (ph == 0) grid.sync(); else { bar_target += gridDim.x; grid_barrier(bar, bar_target); } } } ++ph;
    PHASE_BEGIN phase_convert(p, smem); PHASE_END
    for (int l = 0; l < DEPTH; ++l) {
        const float lam_init = 0.8f - 0.6f * expf(-0.3f * (float)l);
        float d1 = 0.f, d2 = 0.f;
        for (int i = 0; i < 64; ++i) { d1 += p.lq1[l * 64 + i] * p.lk1[l * 64 + i]; d2 += p.lq2[l * 64 + i] * p.lk2[l * 64 + i]; }
        const float lam = expf(d1) - expf(d2) + lam_init;
        PHASE_BEGIN phase_inproj(p, l, smem); PHASE_END
        PHASE_BEGIN phase_attn(p, l, lam, lam_init, smem, &s_item); PHASE_END
        PHASE_BEGIN phase_branch(p, l, smem); PHASE_END
        PHASE_BEGIN phase_resid(p, (const bf16_t*)(p.ws + OFF_QKDA), 1024, (const bf16_t*)(p.ws + OFF_WT_MIX + l * SZ_WT_MIX), 1024,
                                l == 0 ? p.x : nullptr, (float*)(p.ws + OFF_SSQ_FFN), smem); PHASE_END
        PHASE_BEGIN phase_up(p, l, smem); PHASE_END
        PHASE_BEGIN phase_resid(p, (const bf16_t*)(p.ws + OFF_GATES), DFF, (const bf16_t*)(p.ws + OFF_WT_DN + l * SZ_WT_DN), DFF, nullptr,
                                (float*)(p.ws + OFF_SSQ_MIX), smem); PHASE_END
    }
    if (ph >= phase_lo && ph < phase_hi) phase_final(p);
}

extern "C" void kernel_launch(void* const* d_in, const int* in_sizes, int n_in, void* d_out, int out_size, void* d_ws, size_t ws_size,
                              hipStream_t stream) {
    static int grid_blocks = 0;
    if (!grid_blocks) {
        int dev = 0, cus = 0, per_cu = 0;
        hipGetDevice(&dev);
        hipDeviceGetAttribute(&cus, hipDeviceAttributeMultiprocessorCount, dev);
        hipOccupancyMaxActiveBlocksPerMultiprocessor(&per_cu, mega_kernel, NTHR, 0);
        if (per_cu > 1) per_cu = 1;
        if (per_cu < 1) per_cu = 1;
        grid_blocks = cus * per_cu;
    }
    Params p{};
    const float* const* in = (const float* const*)d_in;
    p.x = in[0]; p.norm_mix_w = in[1]; p.w_in = in[2]; p.lq1 = in[3]; p.lk1 = in[4]; p.lq2 = in[5]; p.lk2 = in[6];
    p.subln_w = in[7]; p.sinks = in[8]; p.w_br_da = in[9]; p.w_br_sw = in[10]; p.w_mix_out = in[11]; p.norm_ffn_w = in[12];
    p.w_up = in[13]; p.conv_w = in[14]; p.conv_b = in[15]; p.w_down = in[16]; p.norm_final_w = in[17];
    p.out = (float*)d_out;
    p.ws = (char*)d_ws;
    if (ws_size < WS_TOTAL) { fprintf(stderr, "workspace too small: %zu < %zu\n", ws_size, (size_t)WS_TOTAL); return; }
#ifndef MULTI_LAUNCH
#define MULTI_LAUNCH 0
#endif
#if MULTI_LAUNCH
    for (int ph = 0; ph < 2 + 6 * DEPTH; ++ph) mega_kernel<<<dim3(grid_blocks), dim3(NTHR), 0, stream>>>(p, ph, ph + 1, 0);
#else
    int lo = 0, hi = 1000, us = 1;
    void* args[] = {&p, &lo, &hi, &us};
    hipMemsetAsync((char*)d_ws + OFF_CTR, 0, 256, stream);
    hipError_t e = hipLaunchCooperativeKernel((void*)mega_kernel, dim3(grid_blocks), dim3(NTHR), args, 0, stream);
    if (e != hipSuccess) fprintf(stderr, "cooperative launch failed: %s (grid %d)\n", hipGetErrorString(e), grid_blocks);
#endif
}
```

```cpp
#include <hip/hip_runtime.h>
#include <hip/hip_cooperative_groups.h>
#include <cstdio>
namespace cg = cooperative_groups;

typedef unsigned short bf16_t;
typedef short bf16x8 __attribute__((ext_vector_type(8)));
typedef float f32x16 __attribute__((ext_vector_type(16)));
typedef float f32x4 __attribute__((ext_vector_type(4)));
typedef unsigned u32x4 __attribute__((ext_vector_type(4)));
typedef unsigned u32x2 __attribute__((ext_vector_type(2)));

#define DEVI __device__ __forceinline__

constexpr int DM = 1024, NTOK = 16384, SEQ = 4096, DEPTH = 4;
constexpr int INC = 4352, DFF = 2816, DFF2 = 5632;
constexpr float EPS = 1e-6f;
constexpr float LOG2E = 1.4426950408889634f;
constexpr float QSCALE = 0.125f * LOG2E;

constexpr size_t SZ_WT_IN = (size_t)INC * DM * 2, SZ_WT_BR = (size_t)DM * 512 * 2, SZ_WT_MIX = (size_t)DM * DM * 2,
                 SZ_WT_UP = (size_t)DFF2 * DM * 2, SZ_WT_DN = (size_t)DM * DFF * 2;
constexpr size_t OFF_WT_IN = 0;
constexpr size_t OFF_WT_DA = OFF_WT_IN + DEPTH * SZ_WT_IN;
constexpr size_t OFF_WT_SW = OFF_WT_DA + DEPTH * SZ_WT_BR;
constexpr size_t OFF_WT_MIX = OFF_WT_SW + DEPTH * SZ_WT_BR;
constexpr size_t OFF_WT_UP = OFF_WT_MIX + DEPTH * SZ_WT_MIX;
constexpr size_t OFF_WT_DN = OFF_WT_UP + DEPTH * SZ_WT_UP;
constexpr size_t OFF_XB = OFF_WT_DN + DEPTH * SZ_WT_DN;
constexpr size_t OFF_SSQ_MIX = OFF_XB + (size_t)NTOK * DM * 2;
constexpr size_t OFF_SSQ_FFN = OFF_SSQ_MIX + (size_t)NTOK * 16 * 4;
constexpr size_t OFF_CTR = OFF_SSQ_FFN + (size_t)NTOK * 16 * 4;
constexpr size_t OFF_QKDA = OFF_CTR + 256;
constexpr size_t OFF_VTDA = OFF_QKDA + (size_t)NTOK * 1024 * 2;
constexpr size_t OFF_QSW = OFF_VTDA + (size_t)NTOK * 512 * 2;
constexpr size_t OFF_KSW = OFF_QSW + (size_t)NTOK * 512 * 2;
constexpr size_t OFF_VTSW = OFF_KSW + (size_t)NTOK * 128 * 2;
constexpr size_t OFF_GATES = OFF_VTSW + (size_t)NTOK * 128 * 2;
constexpr size_t OFF_Y = OFF_GATES + (size_t)NTOK * 2048 * 2;
constexpr size_t OFF_BAR = OFF_Y + (size_t)NTOK * 1024 * 2;
constexpr size_t WS_TOTAL = OFF_BAR + 16384;

struct Params {
    const float *x, *norm_mix_w, *w_in, *lq1, *lk1, *lq2, *lk2, *subln_w, *sinks, *w_br_da, *w_br_sw, *w_mix_out,
        *norm_ffn_w, *w_up, *conv_w, *conv_b, *w_down, *norm_final_w;
    float* out;
    char* ws;
};

constexpr int NTHR = 512;
constexpr int RSTD_OFF = 147456;
constexpr int SMEM_BYTES = 147456 + 2048;

typedef __bf16 bf16v2 __attribute__((ext_vector_type(2)));
typedef float f32x2 __attribute__((ext_vector_type(2)));
DEVI unsigned pk_bf16(float lo, float hi) {
    bf16v2 r = __builtin_convertvector((f32x2){lo, hi}, bf16v2);
    return __builtin_bit_cast(unsigned, r);
}
DEVI float bf2f_lo(unsigned u) { return __uint_as_float(u << 16); }
DEVI float bf2f_hi(unsigned u) { return __uint_as_float(u & 0xffff0000u); }
DEVI float fast_sigmoid(float x) { return __builtin_amdgcn_rcpf(1.0f + __builtin_amdgcn_exp2f(-x * LOG2E)); }
DEVI float sum_halves(float v) {
    u32x2 r = __builtin_amdgcn_permlane32_swap(__float_as_uint(v), __float_as_uint(v), false, false);
    return __uint_as_float(r[0]) + __uint_as_float(r[1]);
}
DEVI float max_halves(float v) {
    u32x2 r = __builtin_amdgcn_permlane32_swap(__float_as_uint(v), __float_as_uint(v), false, false);
    return fmaxf(__uint_as_float(r[0]), __uint_as_float(r[1]));
}
DEVI float row_ssq(const float* __restrict__ ssq, int tok) {
    const f32x4 a = *(const f32x4*)(ssq + (size_t)tok * 16), b = *(const f32x4*)(ssq + (size_t)tok * 16 + 4),
                c = *(const f32x4*)(ssq + (size_t)tok * 16 + 8), d = *(const f32x4*)(ssq + (size_t)tok * 16 + 12);
    return ((a[0] + a[1]) + (a[2] + a[3])) + ((b[0] + b[1]) + (b[2] + b[3])) + ((c[0] + c[1]) + (c[2] + c[3])) + ((d[0] + d[1]) + (d[2] + d[3]));
}
DEVI int opaque_tid() { int t = threadIdx.x; asm volatile("" : "+v"(t)); return t; }

__device__ __forceinline__ void convert_weights(const Params& p, char* smem, int l_lo, int l_hi, int vb, int nvb) {
    const int tid = opaque_tid();
    const int half = tid >> 8, ht = tid & 255;
    float* T = (float*)smem + half * (64 * 65);
    const int total = (l_hi - l_lo) * 3712;
    const int iters = (total + 2 * nvb - 1) / (2 * nvb);
    for (int it = 0; it < iters; ++it) {
        const int t = (it * nvb + vb) * 2 + half;
        const bool act = t < total;
        const int l = l_lo + (act ? t / 3712 : 0);
        int r = act ? t % 3712 : 0;
        const float* W;
        const float* sc = nullptr;
        bf16_t* D;
        int K, N, mode = 0, scmask = 0x7fffffff;
        float scmul = 1.0f;
        if (r < 1088) {
            W = p.w_in + (size_t)l * DM * INC; K = DM; N = INC; sc = p.norm_mix_w + l * DM;
            D = (bf16_t*)(p.ws + OFF_WT_IN + l * SZ_WT_IN);
        } else if ((r -= 1088) < 128) {
            W = p.w_br_da + (size_t)l * 512 * DM; K = 512; N = DM; D = (bf16_t*)(p.ws + OFF_WT_DA + l * SZ_WT_BR);
            sc = p.subln_w + l * 128; scmask = 127; scmul = 1.0f - (0.8f - 0.6f * expf(-0.3f * (float)l));
        } else if ((r -= 128) < 128) {
            W = p.w_br_sw + (size_t)l * 512 * DM; K = 512; N = DM; D = (bf16_t*)(p.ws + OFF_WT_SW + l * SZ_WT_BR);
        } else if ((r -= 128) < 256) {
            W = p.w_mix_out + (size_t)l * DM * DM; K = DM; N = DM; D = (bf16_t*)(p.ws + OFF_WT_MIX + l * SZ_WT_MIX);
        } else if ((r -= 256) < 1408) {
            W = p.w_up + (size_t)l * DM * DFF2; K = DM; N = DFF2; sc = p.norm_ffn_w + l * DM; mode = 1;
            D = (bf16_t*)(p.ws + OFF_WT_UP + l * SZ_WT_UP);
        } else {
            r -= 1408;
            W = p.w_down + (size_t)l * DFF * DM; K = DFF; N = DM; D = (bf16_t*)(p.ws + OFF_WT_DN + l * SZ_WT_DN);
        }
        const int ntn = N >> 6;
        const int k0 = (r / ntn) * 64, n0 = (r % ntn) * 64;
        __syncthreads();
        if (act) {
#pragma unroll
            for (int i = 0; i < 4; ++i) {
                const int kr = (ht >> 4) + 16 * i, c4 = (ht & 15) * 4;
                f32x4 v = *(const f32x4*)(W + (size_t)(k0 + kr) * N + n0 + c4);
                const float s_ = sc ? sc[(k0 + kr) & scmask] * scmul : 1.0f;
                T[kr * 65 + c4 + 0] = v[0] * s_; T[kr * 65 + c4 + 1] = v[1] * s_;
                T[kr * 65 + c4 + 2] = v[2] * s_; T[kr * 65 + c4 + 3] = v[3] * s_;
            }
        }
        __syncthreads();
        if (act) {
            const int nl = ht >> 2, kc = (ht & 3) * 16;
            int n = n0 + nl;
            if (mode == 1) n = (n < DFF) ? ((n >> 7) * 256 + (n & 127)) : (((n - DFF) >> 7) * 256 + 128 + ((n - DFF) & 127));
            unsigned o[8];
#pragma unroll
            for (int e = 0; e < 8; ++e) o[e] = pk_bf16(T[(kc + 2 * e) * 65 + nl], T[(kc + 2 * e + 1) * 65 + nl]);
            bf16_t* dst = D + (size_t)n * K + k0 + kc;
            *(u32x4*)dst = (u32x4){o[0], o[1], o[2], o[3]};
            *(u32x4*)(dst + 8) = (u32x4){o[4], o[5], o[6], o[7]};
        }
    }
}

__device__ __forceinline__ void phase_convert(const Params& p, char* smem) {
    convert_weights(p, smem, 0, 1, blockIdx.x, gridDim.x);
    const int tid = opaque_tid();
    {
        const int lane = tid & 63, wave = tid >> 6;
        bf16_t* XB = (bf16_t*)(p.ws + OFF_XB);
        float* ssq = (float*)(p.ws + OFF_SSQ_MIX);
        const int wstride = gridDim.x * 8;
        for (int row0 = blockIdx.x * 8 + wave; row0 < NTOK; row0 += 4 * wstride) {
            f32x4 v[4][4];
#pragma unroll
            for (int rr = 0; rr < 4; ++rr) {
                const int row = row0 + rr * wstride;
                if (row < NTOK) {
#pragma unroll
                    for (int i = 0; i < 4; ++i) v[rr][i] = *(const f32x4*)(p.x + (size_t)row * DM + i * 256 + lane * 4);
                }
            }
#pragma unroll
            for (int rr = 0; rr < 4; ++rr) {
                const int row = row0 + rr * wstride;
                if (row < NTOK) {
                    float s = 0.f;
#pragma unroll
                    for (int i = 0; i < 4; ++i) {
                        s += v[rr][i][0] * v[rr][i][0] + v[rr][i][1] * v[rr][i][1] + v[rr][i][2] * v[rr][i][2] + v[rr][i][3] * v[rr][i][3];
                        *(u32x2*)(XB + (size_t)row * DM + i * 256 + lane * 4) = (u32x2){pk_bf16(v[rr][i][0], v[rr][i][1]), pk_bf16(v[rr][i][2], v[rr][i][3])};
                    }
#pragma unroll
                    for (int o = 32; o >= 1; o >>= 1) s += __shfl_xor(s, o, 64);
                    if (lane < 16) ssq[(size_t)row * 16 + lane] = (lane == 0) ? s : 0.f;
                }
            }
        }
    }
}

DEVI int virt_block() { return (blockIdx.x & 7) * (gridDim.x >> 3) + (blockIdx.x >> 3); }
DEVI void tile_order(int t, int MT, int NT, int& mt, int& nt) {
    const int grp = t / (8 * NT);
    const int first = grp * 8;
    const int gsz = (MT - first) < 8 ? (MT - first) : 8;
    const int rem = t - grp * 8 * NT;
    mt = first + rem % gsz;
    nt = rem / gsz;
}

namespace pg8 {
#define PG8_LAS __attribute__((address_space(3)))
constexpr int BM = 256, BK = 64, HALF = 128, HTB = HALF * BK * 2  , STAGE_BYTES = 8 * HTB, NXCD = 8, WGM = 8;

__host__ __device__ __forceinline__ int lds_byte(int r, int c) { const int st = (r >> 4) * 2 + (c >> 5), rr = r & 15, cc = c & 31, ob = rr * 64 + cc * 2; return st * 1024 + (ob ^ (((ob >> 9) & 1) << 5)); }
__host__ __device__ __forceinline__ void stage_rc(int b, int& R, int& C) { const int st = b / 1024, sb = b % 1024, swz = sb ^ (((sb >> 9) & 1) << 5); R = (st >> 1) * 16 + swz / 64; C = (st & 1) * 32 + (swz % 64) / 2; }
__host__ __device__ __forceinline__ int perm32(int rho) { const int n = rho >> 4, i = rho & 15; return 8 * (i >> 2) + 4 * n + (i & 3); }
struct Unit { int pm, pn, idx; };
struct Gemm { const bf16_t* A; const bf16_t* Bt; int M, N, K; };
template <class Epi, class Sched, bool ALIGN_EPI = false, bool SP2 = false>
__device__ __forceinline__ void gemm_phase(PG8_LAS unsigned char* lds, const Gemm g, const Sched& S, const Epi& E) {
    const int tid = opaque_tid(), wid = __builtin_amdgcn_readfirstlane(tid >> 6), lane = tid & 63, wr = wid >> 2, wc = wid & 3, fr = lane & 15, fq = lane >> 4;
    const int K = g.K, nt = K / BK;
    unsigned voffA[2], voffB[2];
#pragma unroll
    for (int i = 0; i < 2; ++i) { int R, C; stage_rc(tid * 16 + i * 8192, R, C); const int Rb = Epi::PERM ? ((R & ~31) + perm32(R & 31)) : R;
        voffA[i] = (unsigned)(R * K + C) * 2u; voffB[i] = (unsigned)(Rb * K + C) * 2u; }
    const size_t kstep = (size_t)(BK * 2);
    const size_t hstep = (size_t)HALF * K * 2;
    const size_t tstep = 2 * hstep;
    const unsigned ldsw = (unsigned)wid * 1024u;
    const int aoff = lds_byte(wr * 64 + fr, fq * 8), boff = lds_byte(wc * 32 + fr, fq * 8);
#define PG8_SA(b, h) (((b) * 2 + (h)) * HTB)
#define PG8_SB(b, h) ((4 + (b) * 2 + (h)) * HTB)
#define PG8_STAGE(bufoff, gbase, voff) do { _Pragma("unroll") for (int _i = 0; _i < 2; ++_i) \
        __builtin_amdgcn_global_load_lds((const unsigned*)((const char*)(gbase) + (voff)[_i]), (PG8_LAS unsigned*)(lds + (bufoff) + ldsw + _i * 8192), 16, 0, 0); } while (0)
#define PG8_LDA(dst, b, h) do { _Pragma("unroll") for (int m = 0; m < 4; ++m) _Pragma("unroll") for (int k = 0; k < 2; ++k) dst[m][k] = *(const PG8_LAS bf16x8*)(lds + PG8_SA(b, h) + aoff + m * 2048 + k * 1024); } while (0)
#define PG8_LDB(dst, b, h) do { _Pragma("unroll") for (int n = 0; n < 2; ++n) _Pragma("unroll") for (int k = 0; k < 2; ++k) dst[n][k] = *(const PG8_LAS bf16x8*)(lds + PG8_SB(b, h) + boff + n * 2048 + k * 1024); } while (0)
#define PG8_MMA(ai, bj, At, Bt) do { __builtin_amdgcn_s_setprio(1); _Pragma("unroll") for (int m = 0; m < 4; ++m) _Pragma("unroll") for (int n = 0; n < 2; ++n) _Pragma("unroll") for (int k = 0; k < 2; ++k) \
        acc[ai][bj][m][n] = __builtin_amdgcn_mfma_f32_16x16x32_bf16(Bt[n][k], At[m][k], acc[ai][bj][m][n], 0, 0, 0); __builtin_amdgcn_s_setprio(0); } while (0)
#define PG8_WAIT_V(n) asm volatile("s_waitcnt vmcnt(" #n ")" ::: "memory")
#define PG8_WAIT_L(n) asm volatile("s_waitcnt lgkmcnt(" #n ")" ::: "memory")
#define PG8_BAR __builtin_amdgcn_s_barrier()
#define PG8_SCHED __builtin_amdgcn_sched_barrier(0)
    Unit cur, nxt; int ui = 0;
    if (!S.next(0, cur)) return;
    f32x4 acc[2][2][4][2];
#pragma unroll
    for (int a = 0; a < 2; ++a)
#pragma unroll
        for (int b = 0; b < 2; ++b)
#pragma unroll
            for (int m = 0; m < 4; ++m)
#pragma unroll
                for (int n = 0; n < 2; ++n) acc[a][b][m][n] = (f32x4){0.f, 0.f, 0.f, 0.f};
    bf16x8 At[4][2], B0[2][2], B1[2][2];
    const char* cA = S.a_ptr(g, cur); const char* cB = S.b_ptr(g, cur);
    S.a_ready(cur);
    if constexpr (SP2) {
        PG8_STAGE(PG8_SB(0, 0), cB, voffB); PG8_STAGE(PG8_SB(0, 1), cB + hstep, voffB); PG8_STAGE(PG8_SA(0, 0), cA, voffA); PG8_STAGE(PG8_SA(0, 1), cA + hstep, voffA);
        if (wr == 1) PG8_BAR;
        PG8_WAIT_V(2); PG8_BAR;
        PG8_STAGE(PG8_SB(1, 0), cB + kstep, voffB); PG8_STAGE(PG8_SA(1, 0), cA + kstep, voffA); PG8_STAGE(PG8_SB(1, 1), cB + hstep + kstep, voffB);
        PG8_WAIT_V(6); PG8_BAR;
    } else {
        PG8_STAGE(PG8_SB(0, 0), cB, voffB); PG8_STAGE(PG8_SA(0, 0), cA, voffA); PG8_STAGE(PG8_SB(0, 1), cB + hstep, voffB); PG8_STAGE(PG8_SA(0, 1), cA + hstep, voffA);
        if (wr == 1) PG8_BAR;
        PG8_WAIT_V(4); PG8_BAR;
        PG8_STAGE(PG8_SB(1, 0), cB + kstep, voffB); PG8_STAGE(PG8_SA(1, 0), cA + kstep, voffA); PG8_STAGE(PG8_SB(1, 1), cB + hstep + kstep, voffB);
        PG8_WAIT_V(6); PG8_BAR;
    }
    for (;;) {
        const bool has_next = S.next(ui + 1, nxt);
        const char* nA = has_next ? S.a_ptr(g, nxt) : cA; const char* nB = has_next ? S.b_ptr(g, nxt) : cB;
        for (int t = 0; t < nt; t += 2) {
            const bool last = (t == nt - 2);
            const char* a1 = cA + (size_t)(t + 1) * kstep;
            const char* a2 = last ? nA : cA + (size_t)(t + 2) * kstep; const char* b2 = last ? nB : cB + (size_t)(t + 2) * kstep;
            const char* a3 = a2 + kstep; const char* b3 = b2 + kstep;
            if (last && has_next) S.a_ready(nxt);
            if constexpr (SP2) {
            PG8_LDB(B0, 0, 0); PG8_LDB(B1, 0, 1); PG8_SCHED; PG8_LDA(At, 0, 0); PG8_STAGE(PG8_SA(1, 1), a1 + hstep, voffA);
            PG8_WAIT_V(8); PG8_WAIT_L(0); PG8_BAR; PG8_MMA(0, 0, At, B0); PG8_MMA(0, 1, At, B1); PG8_BAR; PG8_SCHED;
            PG8_LDA(At, 0, 1); PG8_STAGE(PG8_SB(0, 0), b2, voffB); PG8_STAGE(PG8_SB(0, 1), b2 + hstep, voffB); PG8_STAGE(PG8_SA(0, 0), a2, voffA);
            PG8_WAIT_V(8); PG8_WAIT_L(0); PG8_BAR; PG8_MMA(1, 0, At, B0); PG8_MMA(1, 1, At, B1); PG8_BAR; PG8_SCHED;
            PG8_LDB(B0, 1, 0); PG8_LDB(B1, 1, 1); PG8_SCHED; PG8_LDA(At, 1, 0); PG8_STAGE(PG8_SA(0, 1), a2 + hstep, voffA);
            PG8_WAIT_V(8); PG8_WAIT_L(0); PG8_BAR; PG8_MMA(0, 0, At, B0); PG8_MMA(0, 1, At, B1); PG8_BAR; PG8_SCHED;
            PG8_LDA(At, 1, 1); PG8_STAGE(PG8_SB(1, 0), b3, voffB); PG8_STAGE(PG8_SB(1, 1), b3 + hstep, voffB); PG8_STAGE(PG8_SA(1, 0), a3, voffA);
            PG8_WAIT_V(8); PG8_WAIT_L(0); PG8_BAR; PG8_MMA(1, 0, At, B0); PG8_MMA(1, 1, At, B1); PG8_BAR; PG8_SCHED;
            } else {
            PG8_LDB(B0, 0, 0); PG8_SCHED; PG8_LDA(At, 0, 0); PG8_STAGE(PG8_SA(1, 1), a1 + hstep, voffA);
            PG8_WAIT_L(8); PG8_BAR; PG8_WAIT_L(0); PG8_MMA(0, 0, At, B0); PG8_BAR; PG8_SCHED;
            PG8_LDB(B1, 0, 1); PG8_STAGE(PG8_SB(0, 0), b2, voffB);
            PG8_BAR; PG8_WAIT_L(0); PG8_MMA(0, 1, At, B1); PG8_BAR;
            PG8_LDA(At, 0, 1); PG8_STAGE(PG8_SA(0, 0), a2, voffA);
            PG8_BAR; PG8_WAIT_L(0); PG8_MMA(1, 0, At, B0); PG8_BAR; PG8_SCHED;
            PG8_STAGE(PG8_SB(0, 1), b2 + hstep, voffB);
            PG8_WAIT_V(6); PG8_BAR; PG8_MMA(1, 1, At, B1); PG8_BAR;
            PG8_LDB(B0, 1, 0); PG8_SCHED; PG8_LDA(At, 1, 0); PG8_STAGE(PG8_SA(0, 1), a2 + hstep, voffA);
            PG8_WAIT_L(8); PG8_BAR; PG8_WAIT_L(0); PG8_MMA(0, 0, At, B0); PG8_BAR; PG8_SCHED;
            PG8_LDB(B1, 1, 1); PG8_STAGE(PG8_SB(1, 0), b3, voffB);
            PG8_BAR; PG8_WAIT_L(0); PG8_MMA(0, 1, At, B1); PG8_BAR;
            PG8_LDA(At, 1, 1); PG8_STAGE(PG8_SA(1, 0), a3, voffA);
            PG8_BAR; PG8_WAIT_L(0); PG8_MMA(1, 0, At, B0); PG8_BAR; PG8_SCHED;
            PG8_STAGE(PG8_SB(1, 1), b3 + hstep, voffB);
            PG8_WAIT_V(6); PG8_BAR; PG8_MMA(1, 1, At, B1); PG8_BAR;
            }
        }
        if constexpr (ALIGN_EPI) { if (wr == 0) PG8_BAR; }
        if constexpr (!Epi::AFTER_DRAIN) { E(acc, cur, wr, wc, fr, fq); S.done(cur); }
        if (!has_next) break;
        if (!S.keep(nxt)) {
#pragma unroll
        for (int a = 0; a < 2; ++a)
#pragma unroll
            for (int b = 0; b < 2; ++b)
#pragma unroll
                for (int m = 0; m < 4; ++m)
#pragma unroll
                    for (int n = 0; n < 2; ++n) acc[a][b][m][n] = (f32x4){0.f, 0.f, 0.f, 0.f};
        }
        cur = nxt; cA = nA; cB = nB; ++ui;
        if constexpr (ALIGN_EPI) { if (wr == 1) PG8_BAR; }
    }
    PG8_WAIT_V(0);
    if constexpr (!ALIGN_EPI) { if (wr == 0) PG8_BAR; }
    PG8_BAR;
    if constexpr (Epi::AFTER_DRAIN) { E.fused(acc, cur, wr, wc, fr, fq, lds, wid, lane); S.done(cur); }
#undef PG8_SA
#undef PG8_SB
#undef PG8_STAGE
#undef PG8_LDA
#undef PG8_LDB
#undef PG8_MMA
#undef PG8_WAIT_V
#undef PG8_WAIT_L
#undef PG8_BAR
#undef PG8_SCHED
}
}

struct TileSched {
    int MT, NT, vb, G;
    DEVI bool next(int i, pg8::Unit& u) const {
        const int t = i * G + vb;
        if (t >= MT * NT) return false;
        tile_order(t, MT, NT, u.pm, u.pn);
        u.idx = i;
        return true;
    }
    DEVI const char* a_ptr(const pg8::Gemm& g, const pg8::Unit& u) const { return (const char*)g.A + (size_t)u.pm * 256 * g.K * 2; }
    DEVI const char* b_ptr(const pg8::Gemm& g, const pg8::Unit& u) const { return (const char*)g.Bt + (size_t)u.pn * 256 * g.K * 2; }
    DEVI bool keep(const pg8::Unit&) const { return false; }
    DEVI void a_ready(const pg8::Unit&) const {}
    DEVI void done(const pg8::Unit&) const {}
};
struct BranchSched {
    int pm, pn; const bf16_t *A1, *A2, *B1, *B2;
    DEVI bool next(int i, pg8::Unit& u) const { if (i > 1) return false; u.pm = pm; u.pn = pn; u.idx = i; return true; }
    DEVI const char* a_ptr(const pg8::Gemm& g, const pg8::Unit& u) const { return (const char*)(u.idx ? A2 : A1) + (size_t)u.pm * 256 * g.K * 2; }
    DEVI const char* b_ptr(const pg8::Gemm& g, const pg8::Unit& u) const { return (const char*)(u.idx ? B2 : B1) + (size_t)u.pn * 256 * g.K * 2; }
    DEVI bool keep(const pg8::Unit& u) const { return u.idx == 1; }
    DEVI void a_ready(const pg8::Unit&) const {}
    DEVI void done(const pg8::Unit&) const {}
};
struct OneUnit {
    pg8::Unit u; long a_row0;
    DEVI bool next(int i, pg8::Unit& o) const { if (i) return false; o = u; return true; }
    DEVI const char* a_ptr(const pg8::Gemm& g, const pg8::Unit&) const { return (const char*)g.A + a_row0 * (long)g.K * 2; }
    DEVI const char* b_ptr(const pg8::Gemm& g, const pg8::Unit& o) const { return (const char*)g.Bt + (size_t)o.pn * 256 * g.K * 2; }
    DEVI bool keep(const pg8::Unit&) const { return false; }
    DEVI void a_ready(const pg8::Unit&) const {}
    DEVI void done(const pg8::Unit&) const {}
};
typedef const __attribute__((address_space(3))) float* lds_cfptr;

struct EpiInproj {
    static constexpr bool PERM = true, AFTER_DRAIN = false;
    char* ws; lds_cfptr rstd_all;
    DEVI void operator()(const f32x4 (&acc)[2][2][4][2], const pg8::Unit& u, int wr, int wc, int fr, int fq) const {
        lds_cfptr rs_u = rstd_all + u.idx * 256;
        const int m0 = u.pm * 256;
#pragma unroll
        for (int bj = 0; bj < 2; ++bj) {
            const int cb = u.pn * 256 + bj * 128 + wc * 32;
            const bool isv = (cb >= 1024 && cb < 1536) || (cb >= 2176 && cb < 2304);
            if (!isv) {
                bf16_t* dst; int ld, coff, mode;
                if (cb < 512) { dst = (bf16_t*)(ws + OFF_QKDA); ld = 1024; coff = cb; mode = 0; }
                else if (cb < 1024) { dst = (bf16_t*)(ws + OFF_QKDA); ld = 1024; coff = cb; mode = 1; }
                else if (cb < 2048) { dst = (bf16_t*)(ws + OFF_QSW); ld = 512; coff = cb - 1536; mode = 0; }
                else if (cb < 2176) { dst = (bf16_t*)(ws + OFF_KSW); ld = 128; coff = cb - 2048; mode = 1; }
                else { dst = (bf16_t*)(ws + OFF_GATES); ld = 2048; coff = cb - 2304; mode = 2; }
#pragma unroll
                for (int ai = 0; ai < 2; ++ai)
#pragma unroll
                    for (int m = 0; m < 4; ++m) {
                        const int rl = ai * 128 + wr * 64 + m * 16 + fr;
                        float rs = rs_u[rl];
                        if (mode == 0) rs *= QSCALE;
                        f32x4 v0 = acc[ai][bj][m][0] * rs, v1 = acc[ai][bj][m][1] * rs;
                        if (mode == 2) {
#pragma unroll
                            for (int e = 0; e < 4; ++e) { v0[e] = fast_sigmoid(v0[e]); v1[e] = fast_sigmoid(v1[e]); }
                        }
                        *(u32x4*)(dst + (size_t)(m0 + rl) * ld + coff + fq * 8) =
                            (u32x4){pk_bf16(v0[0], v0[1]), pk_bf16(v0[2], v0[3]), pk_bf16(v1[0], v1[1]), pk_bf16(v1[2], v1[3])};
                    }
            } else {
                bf16_t* dst; int rowbase, rows_per_b;
                const int b = m0 >> 12, s0 = m0 & 4095;
                if (cb < 1536) { dst = (bf16_t*)(ws + OFF_VTDA); rowbase = cb - 1024; rows_per_b = 512; }
                else { dst = (bf16_t*)(ws + OFF_VTSW); rowbase = cb - 2176; rows_per_b = 128; }
#pragma unroll
                for (int ai = 0; ai < 2; ++ai)
#pragma unroll
                    for (int m = 0; m < 4; ++m) {
                        const int rl = ai * 128 + wr * 64 + m * 16 + fr;
                        const float rs = rs_u[rl];
                        bf16_t* d = dst + (size_t)(b * rows_per_b + rowbase + fq * 8) * SEQ + s0 + rl;
#pragma unroll
                        for (int n = 0; n < 2; ++n)
#pragma unroll
                            for (int e = 0; e < 4; e += 2) {
                                const unsigned pk = pk_bf16(acc[ai][bj][m][n][e] * rs, acc[ai][bj][m][n][e + 1] * rs);
                                d[(size_t)(4 * n + e) * SEQ] = (bf16_t)(pk & 0xffffu);
                                d[(size_t)(4 * n + e + 1) * SEQ] = (bf16_t)(pk >> 16);
                            }
                    }
            }
        }
    }
};

struct EpiBranch {
    static constexpr bool PERM = true, AFTER_DRAIN = false;
    char* ws;
    DEVI void operator()(f32x4 (&acc)[2][2][4][2], const pg8::Unit& u, int wr, int wc, int fr, int fq) const {
        asm volatile("" : "+v"(fr), "+v"(fq));
        const bf16_t* G = (const bf16_t*)(ws + OFF_GATES);
        bf16_t* MG = (bf16_t*)(ws + OFF_QKDA);
        const int m0 = u.pm * 256, c0 = u.pn * 256 + wc * 32 + fq * 8;
        if (u.idx == 0) {
#pragma unroll
            for (int am = 0; am < 8; ++am) {
                const int ai = am >> 2, m = am & 3;
                u32x4 g1[2], g2[2];
#pragma unroll
                for (int bj = 0; bj < 2; ++bj) {
                    const bf16_t* gp = G + (size_t)(m0 + ai * 128 + wr * 64 + m * 16 + fr) * 2048 + c0 + bj * 128;
                    g1[bj] = *(const u32x4*)gp;
                    g2[bj] = *(const u32x4*)(gp + 1024);
                }
#pragma unroll
                for (int bj = 0; bj < 2; ++bj)
#pragma unroll
                    for (int n = 0; n < 2; ++n) {
                        const unsigned a = g1[bj][2 * n], b = g1[bj][2 * n + 1], c = g2[bj][2 * n], d = g2[bj][2 * n + 1];
                        acc[ai][bj][m][n][0] *= bf2f_lo(a) * __builtin_amdgcn_rcpf(bf2f_lo(c));
                        acc[ai][bj][m][n][1] *= bf2f_hi(a) * __builtin_amdgcn_rcpf(bf2f_hi(c));
                        acc[ai][bj][m][n][2] *= bf2f_lo(b) * __builtin_amdgcn_rcpf(bf2f_lo(d));
                        acc[ai][bj][m][n][3] *= bf2f_hi(b) * __builtin_amdgcn_rcpf(bf2f_hi(d));
                    }
                __builtin_amdgcn_sched_barrier(0);
            }
        } else {
#pragma unroll
            for (int am = 0; am < 8; ++am) {
                const int ai = am >> 2, m = am & 3;
                u32x4 g2[2];
#pragma unroll
                for (int bj = 0; bj < 2; ++bj) g2[bj] = *(const u32x4*)(G + (size_t)(m0 + ai * 128 + wr * 64 + m * 16 + fr) * 2048 + 1024 + c0 + bj * 128);
#pragma unroll
                for (int bj = 0; bj < 2; ++bj) {
                    const u32x4 gg = g2[bj];
                    const f32x4 a0 = acc[ai][bj][m][0], a1 = acc[ai][bj][m][1];
                    *(u32x4*)(MG + (size_t)(m0 + ai * 128 + wr * 64 + m * 16 + fr) * 1024 + c0 + bj * 128) =
                        (u32x4){pk_bf16(a0[0] * bf2f_lo(gg[0]), a0[1] * bf2f_hi(gg[0])), pk_bf16(a0[2] * bf2f_lo(gg[1]), a0[3] * bf2f_hi(gg[1])),
                                pk_bf16(a1[0] * bf2f_lo(gg[2]), a1[1] * bf2f_hi(gg[2])), pk_bf16(a1[2] * bf2f_lo(gg[3]), a1[3] * bf2f_hi(gg[3]))};
                }
                if (am & 1) __builtin_amdgcn_sched_barrier(0);
            }
        }
    }
};

struct EpiResid {
    static constexpr bool PERM = true, AFTER_DRAIN = false;
    char* ws; const float* xold; float* ssq;
    DEVI void operator()(const f32x4 (&acc)[2][2][4][2], const pg8::Unit& u, int wr, int wc, int fr, int fq) const {
        bf16_t* XB = (bf16_t*)(ws + OFF_XB);
        const int m0 = u.pm * 256, c0 = u.pn * 256 + wc * 32 + fq * 8;
#pragma unroll
        for (int ai = 0; ai < 2; ++ai) {
            u32x4 xo[4][2];
            if (!xold) {
#pragma unroll
                for (int m = 0; m < 4; ++m)
#pragma unroll
                    for (int bj = 0; bj < 2; ++bj) xo[m][bj] = *(const u32x4*)(XB + (size_t)(m0 + ai * 128 + wr * 64 + m * 16 + fr) * DM + c0 + bj * 128);
            }
#pragma unroll
            for (int m = 0; m < 4; ++m) {
                const int tok = m0 + ai * 128 + wr * 64 + m * 16 + fr;
                float sq = 0.f;
#pragma unroll
                for (int bj = 0; bj < 2; ++bj) {
                    f32x4 a0, a1;
                    if (xold) { a0 = *(const f32x4*)(xold + (size_t)tok * DM + c0 + bj * 128); a1 = *(const f32x4*)(xold + (size_t)tok * DM + c0 + bj * 128 + 4); }
                    else {
                        const u32x4 w = xo[m][bj];
                        a0 = (f32x4){bf2f_lo(w[0]), bf2f_hi(w[0]), bf2f_lo(w[1]), bf2f_hi(w[1])};
                        a1 = (f32x4){bf2f_lo(w[2]), bf2f_hi(w[2]), bf2f_lo(w[3]), bf2f_hi(w[3])};
                    }
                    a0 += acc[ai][bj][m][0]; a1 += acc[ai][bj][m][1];
                    sq += a0[0] * a0[0] + a0[1] * a0[1] + a0[2] * a0[2] + a0[3] * a0[3] + a1[0] * a1[0] + a1[1] * a1[1] + a1[2] * a1[2] + a1[3] * a1[3];
                    *(u32x4*)(XB + (size_t)tok * DM + c0 + bj * 128) = (u32x4){pk_bf16(a0[0], a0[1]), pk_bf16(a0[2], a0[3]), pk_bf16(a1[0], a1[1]), pk_bf16(a1[2], a1[3])};
                }
                sq += __shfl_xor(sq, 16, 64);
                sq = sum_halves(sq);
                if (fq == 0) ssq[(size_t)tok * 16 + u.pn * 4 + wc] = sq;
            }
        }
    }
};

constexpr int USTRB = 520;
struct EpiUp {
    static constexpr bool PERM = true, AFTER_DRAIN = true;
    char* ws; const float* cw; const float* cb; lds_cfptr rstd_s; int b, pos0, nt;
    DEVI void operator()(const f32x4 (&)[2][2][4][2], const pg8::Unit&, int, int, int, int) const {}
    DEVI void fused(const f32x4 (&acc)[2][2][4][2], const pg8::Unit&, int wr, int wc, int fr, int fq, __attribute__((address_space(3))) unsigned char* lds,
                    int, int) const {
        bf16_t* H = (bf16_t*)(ws + OFF_GATES);
#pragma unroll
        for (int ai = 0; ai < 2; ++ai)
#pragma unroll
            for (int m = 0; m < 4; ++m) {
                const int rl = ai * 128 + wr * 64 + m * 16 + fr;
                const float rs = rstd_s[rl];
#pragma unroll
                for (int bj = 0; bj < 2; ++bj) {
                    const f32x4 v0 = acc[ai][bj][m][0] * rs, v1 = acc[ai][bj][m][1] * rs;
                    *(__attribute__((address_space(3))) u32x4*)(lds + rl * USTRB + (bj * 128 + wc * 32 + fq * 8) * 2) =
                        (u32x4){pk_bf16(v0[0], v0[1]), pk_bf16(v0[2], v0[3]), pk_bf16(v1[0], v1[1]), pk_bf16(v1[2], v1[3])};
                }
            }
        __syncthreads();
        const int tid = threadIdx.x;
        const int j4 = (tid & 31) * 4, r0 = (tid >> 5) * 16;
        const int jg = nt * 128 + j4;
        f32x4 wg[3], wv[3], bg, bv;
#pragma unroll
        for (int i = 0; i < 3; ++i) { wg[i] = *(const f32x4*)(cw + i * DFF2 + jg); wv[i] = *(const f32x4*)(cw + i * DFF2 + DFF + jg); }
        bg = *(const f32x4*)(cb + jg);
        bv = *(const f32x4*)(cb + DFF + jg);
        auto ldrow = [&](int r, f32x4& ug, f32x4& uv) {
            const u32x2 a = *(const __attribute__((address_space(3))) u32x2*)(lds + r * USTRB + j4 * 2);
            const u32x2 c = *(const __attribute__((address_space(3))) u32x2*)(lds + r * USTRB + 256 + j4 * 2);
            ug = (f32x4){bf2f_lo(a[0]), bf2f_hi(a[0]), bf2f_lo(a[1]), bf2f_hi(a[1])};
            uv = (f32x4){bf2f_lo(c[0]), bf2f_hi(c[0]), bf2f_lo(c[1]), bf2f_hi(c[1])};
        };
        f32x4 g2, v2, g1, v1;
        ldrow(r0 >= 2 ? r0 - 2 : 0, g2, v2);
        ldrow(r0 >= 1 ? r0 - 1 : 0, g1, v1);
#pragma unroll 4
        for (int i = 0; i < 16; ++i) {
            const int r = r0 + i;
            f32x4 g0, v0;
            ldrow(r, g0, v0);
            const int pos = pos0 + r;
            if (r >= 2 && pos < SEQ) {
                const f32x4 cg_ = bg + g2 * wg[0] + g1 * wg[1] + g0 * wg[2];
                const f32x4 cv_ = bv + v2 * wv[0] + v1 * wv[1] + v0 * wv[2];
                f32x4 sg;
#pragma unroll
                for (int e = 0; e < 4; ++e) sg[e] = fast_sigmoid(cg_[e]);
                const f32x4 hh = cg_ * sg * cv_;
                *(u32x2*)(H + (size_t)(b * SEQ + pos) * DFF + jg) = (u32x2){pk_bf16(hh[0], hh[1]), pk_bf16(hh[2], hh[3])};
            }
            g2 = g1; v2 = v1; g1 = g0; v1 = v0;
        }
    }
};

__device__ __forceinline__ void phase_inproj(const Params& p, int l, char* smem) {
    const int tid = opaque_tid();
    const float* ssq = (const float*)(p.ws + OFF_SSQ_MIX);
    TileSched S{64, 17, virt_block(), (int)gridDim.x};
    float* rstd_all = (float*)(smem + 131072);
    for (int i = 0; i < 8; ++i) {
        pg8::Unit u;
        if (!S.next(i, u)) break;
        if (tid < 256) rstd_all[i * 256 + tid] = __builtin_amdgcn_rsqf(row_ssq(ssq, u.pm * 256 + tid) * (1.0f / DM) + EPS);
    }
    __syncthreads();
    pg8::Gemm g{(const bf16_t*)(p.ws + OFF_XB), (const bf16_t*)(p.ws + OFF_WT_IN + l * SZ_WT_IN), NTOK, INC, DM};
    EpiInproj E{p.ws, (lds_cfptr)rstd_all};
    pg8::gemm_phase<EpiInproj, TileSched, true, true>((__attribute__((address_space(3))) unsigned char*)smem, g, S, E);
    if (l + 1 < DEPTH) {
        const int ntile = 64 * 17, g_ = gridDim.x, busy = ntile % g_;
        const int vb = virt_block();
        if (busy > 0 && busy < g_) {
            if (vb >= busy) { __syncthreads(); convert_weights(p, smem, l + 1, l + 2, vb - busy, g_ - busy); }
        } else {
            __syncthreads();
            convert_weights(p, smem, l + 1, l + 2, vb, g_);
        }
    }
}

#define CJI(r) (16 * ((r) >> 3) + ((r) & 7))
template <int KROWB, int VROWB, int DV, bool SW>
DEVI void attn_sub(f32x16 (&O)[DV / 32], float& m, float& lsum, const bf16x8 (&qf)[4], const char* Ksub, const char* Vsub, int ks0, int qw,
                   int qpos, int g, float slope2) {
    constexpr int NB = DV / 32;
    const int relbase = ks0 + 8 * g - qpos;
    const float basef = slope2 * (float)relbase;
    const bool need_mask = SW || (ks0 + 31 > qw);
    bf16x8 kf[4], vf[2][NB];
#pragma unroll
    for (int kk = 0; kk < 4; ++kk) kf[kk] = *(const bf16x8*)(Ksub + kk * 32);
#pragma unroll
    for (int t = 0; t < 2; ++t)
#pragma unroll
        for (int b = 0; b < NB; ++b) vf[t][b] = *(const bf16x8*)(Vsub + b * 32 * VROWB + t * 32);
    __builtin_amdgcn_sched_barrier(0);
    f32x16 S;
#pragma unroll
    for (int r = 0; r < 16; ++r) S[r] = __builtin_fmaf(slope2, (float)CJI(r), basef);
#pragma unroll
    for (int kk = 0; kk < 4; ++kk) S = __builtin_amdgcn_mfma_f32_32x32x16_bf16(kf[kk], qf[kk], S, 0, 0, 0);
    if (need_mask) {
#pragma unroll
        for (int r = 0; r < 16; ++r) {
            const int rel = relbase + CJI(r);
            bool valid = rel <= 0;
            if (SW) valid = valid && (rel > -128) && (rel + qpos >= 0);
            S[r] = valid ? S[r] : -1e30f;
        }
    }
    float mx = S[0];
#pragma unroll
    for (int r = 1; r < 16; ++r) mx = fmaxf(mx, S[r]);
    mx = max_halves(mx);
    if (__builtin_amdgcn_ballot_w64(mx > m + 20.0f) != 0ull) {
        const float mn = fmaxf(m, mx);
        const float alpha = __builtin_amdgcn_exp2f(m - mn);
        m = mn;
        lsum *= alpha;
#pragma unroll
        for (int b = 0; b < NB; ++b)
#pragma unroll
            for (int r = 0; r < 16; ++r) O[b][r] *= alpha;
    }
    float ps = 0.f;
#pragma unroll
    for (int r = 0; r < 16; ++r) { S[r] = __builtin_amdgcn_exp2f(S[r] - m); ps += S[r]; }
    lsum += ps;
    bf16x8 P[2];
#pragma unroll
    for (int t = 0; t < 2; ++t) {
        u32x4 pk = (u32x4){pk_bf16(S[8 * t + 0], S[8 * t + 1]), pk_bf16(S[8 * t + 2], S[8 * t + 3]), pk_bf16(S[8 * t + 4], S[8 * t + 5]),
                           pk_bf16(S[8 * t + 6], S[8 * t + 7])};
        P[t] = __builtin_bit_cast(bf16x8, pk);
    }
#pragma unroll
    for (int t = 0; t < 2; ++t)
#pragma unroll
        for (int b = 0; b < NB; ++b) O[b] = __builtin_amdgcn_mfma_f32_32x32x16_bf16(vf[t][b], P[t], O[b], 0, 0, 0);
}

template <int KW, int DV, bool SW>
DEVI void attn_item(const bf16_t* __restrict__ Qp, int ldq, const bf16_t* __restrict__ Kp, int ldk, const bf16_t* __restrict__ VTp,
                    bf16_t* __restrict__ Yp, int ldy, int qw, int map, int kbeg, int kend, float slope2, float sink2, float lam, char* smem) {
    constexpr int KROWB = KW * 128 + 16;
    constexpr int VROWB = 272;
    constexpr int KCH = KW * 8;
    constexpr int NB = DV / 32;
    constexpr int KN = (128 * KCH) / NTHR, VN = (DV * 16) / NTHR;
    constexpr int ASTAGE = 128 * KROWB + DV * VROWB;
    const int tid = opaque_tid(), lane = tid & 63, q = lane & 31, g = lane >> 5, wave = __builtin_amdgcn_readfirstlane(tid >> 6);
    const int qpos = qw + q;
    bf16x8 qf[4];
#pragma unroll
    for (int kk = 0; kk < 4; ++kk) qf[kk] = *(const bf16x8*)(Qp + (size_t)qpos * ldq + map * 64 + kk * 16 + g * 8);
    f32x16 O[NB];
#pragma unroll
    for (int b = 0; b < NB; ++b)
#pragma unroll
        for (int r = 0; r < 16; ++r) O[b][r] = 0.f;
    float m = SW ? sink2 : -1e30f, lsum = (SW && g == 0) ? 1.f : 0.f;
    const int pr = (q & 0x13) | ((q & 4) << 1) | ((q & 8) >> 1);
    const int kw_off = pr * KROWB + g * 16 + map * 128;
    const int vw_off = 128 * KROWB + q * VROWB + g * 16;
    u32x4 kreg[KN], vreg[VN];
#define ATT_GLOAD(KT0)                                                                         \
    {                                                                                          \
        _Pragma("unroll") for (int i = 0; i < KN; ++i) {                                       \
            const int id = tid + NTHR * i, row = id / KCH, ch = id % KCH;                      \
            int tok = (KT0) + row;                                                             \
            tok = tok < 0 ? 0 : (tok > SEQ - 1 ? SEQ - 1 : tok);                               \
            kreg[i] = *(const u32x4*)(Kp + (size_t)tok * ldk + ch * 8);                        \
        }                                                                                      \
        _Pragma("unroll") for (int i = 0; i < VN; ++i) {                                       \
            const int id = tid + NTHR * i, r = id >> 4, ch = id & 15;                          \
            int s_ = (KT0) + ch * 8;                                                           \
            s_ = s_ < 0 ? 0 : (s_ > SEQ - 8 ? SEQ - 8 : s_);                                   \
            vreg[i] = *(const u32x4*)(VTp + (size_t)r * SEQ + s_);                             \
        }                                                                                      \
    }
#define ATT_LSTORE(BUF)                                                                        \
    {                                                                                          \
        char* D_ = smem + (BUF) * ASTAGE;                                                      \
        _Pragma("unroll") for (int i = 0; i < KN; ++i) { const int id = tid + NTHR * i, row = id / KCH, ch = id % KCH; *(u32x4*)(D_ + row * KROWB + ch * 16) = kreg[i]; } \
        _Pragma("unroll") for (int i = 0; i < VN; ++i) { const int id = tid + NTHR * i, r = id >> 4, ch = id & 15; *(u32x4*)(D_ + 128 * KROWB + r * VROWB + ch * 16) = vreg[i]; } \
    }
    int kt0 = kbeg;
    if (SW) { while (kt0 + 127 < 0) kt0 += 128; }
    ATT_GLOAD(kt0)
    __syncthreads();
    ATT_LSTORE(0)
    if (kt0 + 128 < kend) ATT_GLOAD(kt0 + 128)
    __syncthreads();
    int cur = 0;
    for (; kt0 < kend; kt0 += 128) {
        const char* St = smem + cur * ASTAGE;
#pragma unroll 1
        for (int sub = 0; sub < 4; ++sub) {
            const int ks0 = kt0 + 32 * sub;
            if (ks0 > qw + 31) break;
            if (SW && (ks0 + 31 < qw - 127 || ks0 + 31 < 0)) continue;
            attn_sub<KROWB, VROWB, DV, SW>(O, m, lsum, qf, St + kw_off + sub * 32 * KROWB, St + vw_off + sub * 64, ks0, qw, qpos, g, slope2);
        }
        if (kt0 + 128 < kend) {
            ATT_LSTORE(cur ^ 1)
            if (kt0 + 256 < kend) ATT_GLOAD(kt0 + 256)
        }
        __syncthreads();
        cur ^= 1;
    }
#undef ATT_GLOAD
#undef ATT_LSTORE
    const float lt = sum_halves(lsum);
    if (!SW) {
        __syncthreads();
        char* X = smem + (wave >> 1) * 16384;
        const float sc = (map ? lam : 1.0f) / lt;
#pragma unroll
        for (int b = 0; b < NB; ++b)
#pragma unroll
            for (int r = 0; r < 16; ++r) O[b][r] *= sc;
        if (map) {
#pragma unroll
            for (int b = 0; b < NB; ++b)
#pragma unroll
                for (int j = 0; j < 4; ++j)
                    *(f32x4*)(X + ((b * 4 + j) * 64 + lane) * 16) = (f32x4){O[b][4 * j + 0], O[b][4 * j + 1], O[b][4 * j + 2], O[b][4 * j + 3]};
        }
        __syncthreads();
        if (!map) {
            float ss = 0.f;
#pragma unroll
            for (int b = 0; b < NB; ++b)
#pragma unroll
                for (int j = 0; j < 4; ++j) {
                    const f32x4 ob = *(const f32x4*)(X + ((b * 4 + j) * 64 + lane) * 16);
#pragma unroll
                    for (int i = 0; i < 4; ++i) {
                        const float a = O[b][4 * j + i] - ob[i];
                        O[b][4 * j + i] = a;
                        ss += a * a;
                    }
                }
            ss = sum_halves(ss);
            const float rn = __builtin_amdgcn_rsqf(ss * (1.0f / DV) + EPS);
#pragma unroll
            for (int b = 0; b < NB; ++b)
#pragma unroll
                for (int j = 0; j < 4; ++j) {
                    const int dv = 32 * b + 8 * j + 4 * g;
                    *(u32x2*)(Yp + (size_t)qpos * ldy + dv) = (u32x2){pk_bf16(O[b][4 * j + 0] * rn, O[b][4 * j + 1] * rn),
                                                                      pk_bf16(O[b][4 * j + 2] * rn, O[b][4 * j + 3] * rn)};
                }
        }
    } else {
        const float inv0 = 1.0f / lt;
#pragma unroll
        for (int b = 0; b < NB; ++b)
#pragma unroll
            for (int j = 0; j < 4; ++j) {
                const int dv = 32 * b + 8 * j + 4 * g;
                *(u32x2*)(Yp + (size_t)qpos * ldy + dv) = (u32x2){pk_bf16(O[b][4 * j + 0] * inv0, O[b][4 * j + 1] * inv0),
                                                                  pk_bf16(O[b][4 * j + 2] * inv0, O[b][4 * j + 3] * inv0)};
            }
    }
}

__device__ __forceinline__ void phase_attn(const Params& p, int l, float lam, float lam_init, char* smem, int* s_item) {
    const int tid = opaque_tid(), wave = __builtin_amdgcn_readfirstlane(tid >> 6);
    int* ctr = (int*)(p.ws + OFF_CTR) + l;
    const bf16_t* QKDA = (const bf16_t*)(p.ws + OFF_QKDA);
    const bf16_t* VTDA = (const bf16_t*)(p.ws + OFF_VTDA);
    const bf16_t* QSW = (const bf16_t*)(p.ws + OFF_QSW);
    const bf16_t* KSW = (const bf16_t*)(p.ws + OFF_KSW);
    const bf16_t* VTSW = (const bf16_t*)(p.ws + OFF_VTSW);
    bf16_t* Y = (bf16_t*)(p.ws + OFF_Y);
    const int xcd = blockIdx.x & 7, slot = blockIdx.x >> 3, nslots = gridDim.x >> 3;
    (void)ctr; (void)s_item;
    for (int r = 0; r < 2; ++r)
        for (int j = slot; j < 32; j += nslots) {
            const int qb = r ? 31 - j : j, bh = 2 * xcd + r, b = bh >> 2, h = bh & 3;
            const int q0 = qb * 128;
            const float slope2 = exp2f(-2.0f * (h + 1)) * LOG2E;
            __syncthreads();
            attn_item<2, 128, false>(QKDA + (size_t)b * SEQ * 1024 + h * 128, 1024, QKDA + (size_t)b * SEQ * 1024 + 512 + h * 128, 1024,
                                     VTDA + (size_t)(b * 4 + h) * 128 * SEQ, Y + (size_t)b * SEQ * 512 + h * 128, 512, q0 + 32 * (wave >> 1),
                                     wave & 1, 0, q0 + 128, slope2, 0.f, lam, smem);
        }
    for (int j = slot; j < 64; j += nslots) {
        const int b = xcd >> 1, kvh = xcd & 1;
        const int q0 = j * 64, qw = q0 + 32 * (wave >> 2), head = kvh * 4 + (wave & 3);
        const float slope2 = exp2f(-(float)(head + 1)) * LOG2E;
        const float sink2 = p.sinks[l * 8 + head] * LOG2E;
        __syncthreads();
        attn_item<1, 64, true>(QSW + (size_t)b * SEQ * 512 + head * 64, 512, KSW + (size_t)b * SEQ * 128 + kvh * 64, 128,
                               VTSW + (size_t)(b * 2 + kvh) * 64 * SEQ, Y + (size_t)NTOK * 512 + (size_t)b * SEQ * 512 + head * 64, 512, qw, 0, q0 - 128,
                               q0 + 64, slope2, sink2, 0.f, smem);
    }
}

__device__ __forceinline__ void phase_branch(const Params& p, int l, char* smem) {
    const bf16_t* Yda = (const bf16_t*)(p.ws + OFF_Y);
    const bf16_t* Ysw = Yda + (size_t)NTOK * 512;
    for (int t = virt_block(); t < 64 * 4; t += gridDim.x) {
        int mt, nt;
        tile_order(t, 64, 4, mt, nt);
        BranchSched S{mt, nt, Yda, Ysw, (const bf16_t*)(p.ws + OFF_WT_DA + l * SZ_WT_BR), (const bf16_t*)(p.ws + OFF_WT_SW + l * SZ_WT_BR)};
        pg8::Gemm g{Yda, nullptr, NTOK, DM, 512};
        EpiBranch E{p.ws};
        __syncthreads();
        pg8::gemm_phase<EpiBranch, BranchSched, true, true>((__attribute__((address_space(3))) unsigned char*)smem, g, S, E);
    }
}

__device__ __forceinline__ void phase_resid(const Params& p, const bf16_t* A, int lda, const bf16_t* WT, int K, const float* xold, float* ssq, char* smem) {
    (void)lda;
    TileSched S{64, 4, virt_block(), (int)gridDim.x};
    pg8::Gemm g{A, WT, NTOK, DM, K};
    EpiResid E{p.ws, xold, ssq};
    __syncthreads();
    pg8::gemm_phase<EpiResid, TileSched, false, true>((__attribute__((address_space(3))) unsigned char*)smem, g, S, E);
}

__device__ __forceinline__ void phase_up(const Params& p, int l, char* smem) {
    const int tid = opaque_tid();
    const float* ssq = (const float*)(p.ws + OFF_SSQ_FFN);
    pg8::Gemm g{(const bf16_t*)(p.ws + OFF_XB), (const bf16_t*)(p.ws + OFF_WT_UP + l * SZ_WT_UP), NTOK, DFF2, DM};
    int tpar = 0;
    for (int t = virt_block(); t < 68 * 22; t += gridDim.x) {
        int mt, nt;
        tile_order(t, 68, 22, mt, nt);
        const int b = mt / 17, ti = mt % 17;
        const int pos0 = -2 + 254 * ti;
        float* rstd_s = (float*)(smem + RSTD_OFF) + (tpar & 1) * 256;
        ++tpar;
        if (tid < 256) {
            int pos = pos0 + tid;
            const bool zero = pos < 0;
            pos = pos < 0 ? 0 : (pos > SEQ - 1 ? SEQ - 1 : pos);
            const float rs = __builtin_amdgcn_rsqf(row_ssq(ssq, b * SEQ + pos) * (1.0f / DM) + EPS);
            rstd_s[tid] = zero ? 0.f : rs;
        }
        __syncthreads();
        OneUnit S{{0, nt, 0}, (long)b * SEQ + pos0};
        EpiUp E{p.ws, p.conv_w + (size_t)l * 3 * DFF2, p.conv_b + (size_t)l * DFF2, (lds_cfptr)rstd_s, b, pos0, nt};
        pg8::gemm_phase<EpiUp, OneUnit, false, true>((__attribute__((address_space(3))) unsigned char*)smem, g, S, E);
    }
}

__device__ __forceinline__ void phase_final(const Params& p) {
    const int tid = opaque_tid(), lane = tid & 63, wave = tid >> 6;
    const float* ssq = (const float*)(p.ws + OFF_SSQ_MIX);
    const bf16_t* XB = (const bf16_t*)(p.ws + OFF_XB);
    f32x4 w[4];
#pragma unroll
    for (int i = 0; i < 4; ++i) w[i] = *(const f32x4*)(p.norm_final_w + i * 256 + lane * 4);
    const int wstride = gridDim.x * 8;
    for (int row0 = blockIdx.x * 8 + wave; row0 < NTOK; row0 += 4 * wstride) {
        u32x2 xv[4][4];
        float sq[4];
#pragma unroll
        for (int rr = 0; rr < 4; ++rr) {
            const int row = row0 + rr * wstride;
            if (row < NTOK) {
#pragma unroll
                for (int i = 0; i < 4; ++i) xv[rr][i] = *(const u32x2*)(XB + (size_t)row * DM + i * 256 + lane * 4);
                sq[rr] = row_ssq(ssq, row);
            }
        }
#pragma unroll
        for (int rr = 0; rr < 4; ++rr) {
            const int row = row0 + rr * wstride;
            if (row < NTOK) {
                const float rs = __builtin_amdgcn_rsqf(sq[rr] * (1.0f / DM) + EPS);
                float* xr = p.out + (size_t)row * DM;
#pragma unroll
                for (int i = 0; i < 4; ++i) {
                    f32x4 v;
                    v[0] = bf2f_lo(xv[rr][i][0]) * rs * w[i][0]; v[1] = bf2f_hi(xv[rr][i][0]) * rs * w[i][1];
                    v[2] = bf2f_lo(xv[rr][i][1]) * rs * w[i][2]; v[3] = bf2f_hi(xv[rr][i][1]) * rs * w[i][3];
                    *(f32x4*)(xr + i * 256 + lane * 4) = v;
                }
            }
        }
    }
}

#define XB_TMO      128
#define XB_XCNT(j)  (256  + 64 * (j))
#define XB_XSUB(j)  (1280 + 64 * (j))
#define XB_XGEN(j)  (2304 + 64 * (j))
#define XB_TOP      3328
#define XB_TOPGEN   3392
#define XCD_BAR_WORDS 3456
#define XB_SPIN_CAP (1u << 22)
DEVI unsigned xb_ld(unsigned* p) { return __hip_atomic_load(p, __ATOMIC_RELAXED, __HIP_MEMORY_SCOPE_AGENT); }
DEVI unsigned xb_add(unsigned* p, unsigned v) { return __hip_atomic_fetch_add(p, v, __ATOMIC_RELAXED, __HIP_MEMORY_SCOPE_AGENT); }
DEVI unsigned xb_xcc_id() { return (unsigned)__builtin_amdgcn_s_getreg((3 << 11) | 20) & 0xFu; }
#define XB_SPIN(cond, bar) do { unsigned _sp = 0; while (cond) { __builtin_amdgcn_s_sleep(1); \
    if ((++_sp & 255u) == 0u) { if (xb_ld(&(bar)[XB_TMO])) break; if (_sp > XB_SPIN_CAP) { atomicAdd(&(bar)[XB_TMO], 1u); break; } } } } while (0)
DEVI void xcd_barrier_complete(unsigned* bar, unsigned x, unsigned& nloc, unsigned& nx) {
    const unsigned G = gridDim.x;
    unsigned sum, cnt, mine, sp = 0u;
    for (;;) {
        sum = 0u; cnt = 0u; mine = 0u;
#pragma unroll
        for (unsigned j = 0; j < 16; ++j) { const unsigned c = xb_ld(&bar[XB_XCNT(j)]); sum += c; cnt += (c > 0u) ? 1u : 0u; mine = (j == x) ? c : mine; }
        if (sum == G) break;
        __builtin_amdgcn_s_sleep(1);
        if ((++sp & 255u) == 0u) { if (xb_ld(&bar[XB_TMO])) break; if (sp > XB_SPIN_CAP) { atomicAdd(&bar[XB_TMO], 1u); break; } }
    }
    nloc = mine > 0u ? mine : 1u; nx = cnt > 0u ? cnt : 1u;
}
__device__ __attribute__((noinline)) void xcd_barrier(char* ws, volatile unsigned* st) {
    asm volatile("s_waitcnt vmcnt(0)" ::: "memory");
    __syncthreads();
    if (threadIdx.x == 0) {
        unsigned* bar = (unsigned*)(ws + OFF_BAR);
        const unsigned x = xb_xcc_id();
        __builtin_amdgcn_s_waitcnt(0);
        unsigned nloc = st[0], nx = st[1];
        if (nloc == 0u) { xcd_barrier_complete(bar, x, nloc, nx); st[0] = nloc; st[1] = nx; }
        const unsigned old = xb_add(&bar[XB_XSUB(x)], 1u);
        const unsigned gen = old / nloc;
        if (old + 1u == (gen + 1u) * nloc) {
            __builtin_amdgcn_fence(__ATOMIC_RELEASE, "agent");
            asm volatile("s_waitcnt vmcnt(0)" ::: "memory");
            const unsigned og = xb_add(&bar[XB_TOP], 1u);
            const unsigned tg = og / nx;
            if (og + 1u == (tg + 1u) * nx) xb_add(&bar[XB_TOPGEN], 1u);
            else XB_SPIN(xb_ld(&bar[XB_TOPGEN]) == tg, bar);
            __builtin_amdgcn_fence(__ATOMIC_ACQUIRE, "agent");
            xb_add(&bar[XB_XGEN(x)], 1u);
            asm volatile("s_waitcnt vmcnt(0)" ::: "memory");
        } else {
            XB_SPIN(xb_ld(&bar[XB_XGEN(x)]) == gen, bar);
            __builtin_amdgcn_fence(__ATOMIC_ACQUIRE, "agent");
            asm volatile("s_waitcnt vmcnt(0)" ::: "memory");
        }
    }
    __syncthreads();
}

__global__ void __launch_bounds__(NTHR) mega_kernel(Params p, int phase_lo, int phase_hi, int use_sync) {
    __shared__ __attribute__((aligned(16))) char smem[SMEM_BYTES];
    __shared__ int s_item;
    cg::grid_group grid = cg::this_grid();
    int ph = 0;
#define PHASE_BEGIN if (ph >= phase_lo && ph < phase_hi) {
    __shared__ __attribute__((aligned(16))) unsigned xb_words[4];
    if (threadIdx.x < 4) xb_words[threadIdx.x] = 0u;
    if (threadIdx.x == 0 && use_sync) (void)xb_add(&((unsigned*)(p.ws + OFF_BAR))[XB_XCNT(xb_xcc_id())], 1u);
    __syncthreads();
#define PHASE_END   if (use_sync) { if (phase_lo < 0) grid.sync(); else xcd_barrier(p.ws, xb_words); } } ++ph;
    PHASE_BEGIN phase_convert(p, smem); PHASE_END
    for (int l = 0; l < DEPTH; ++l) {
        const float lam_init = 0.8f - 0.6f * expf(-0.3f * (float)l);
        float d1 = 0.f, d2 = 0.f;
        for (int i = 0; i < 64; ++i) { d1 += p.lq1[l * 64 + i] * p.lk1[l * 64 + i]; d2 += p.lq2[l * 64 + i] * p.lk2[l * 64 + i]; }
        const float lam = expf(d1) - expf(d2) + lam_init;
        PHASE_BEGIN phase_inproj(p, l, smem); PHASE_END
        PHASE_BEGIN phase_attn(p, l, lam, lam_init, smem, &s_item); PHASE_END
        PHASE_BEGIN phase_branch(p, l, smem); PHASE_END
        PHASE_BEGIN phase_resid(p, (const bf16_t*)(p.ws + OFF_QKDA), 1024, (const bf16_t*)(p.ws + OFF_WT_MIX + l * SZ_WT_MIX), 1024,
                                l == 0 ? p.x : nullptr, (float*)(p.ws + OFF_SSQ_FFN), smem); PHASE_END
        PHASE_BEGIN phase_up(p, l, smem); PHASE_END
        PHASE_BEGIN phase_resid(p, (const bf16_t*)(p.ws + OFF_GATES), DFF, (const bf16_t*)(p.ws + OFF_WT_DN + l * SZ_WT_DN), DFF, nullptr,
                                (float*)(p.ws + OFF_SSQ_MIX), smem); PHASE_END
    }
    if (ph >= phase_lo && ph < phase_hi) phase_final(p);
}

extern "C" void kernel_launch(void* const* d_in, const int* in_sizes, int n_in, void* d_out, int out_size, void* d_ws, size_t ws_size,
                              hipStream_t stream) {
    static int grid_blocks = 0;
    if (!grid_blocks) {
        int dev = 0, cus = 0, per_cu = 0;
        hipGetDevice(&dev);
        hipDeviceGetAttribute(&cus, hipDeviceAttributeMultiprocessorCount, dev);
        hipOccupancyMaxActiveBlocksPerMultiprocessor(&per_cu, mega_kernel, NTHR, 0);
        if (per_cu > 1) per_cu = 1;
        if (per_cu < 1) per_cu = 1;
        grid_blocks = cus * per_cu;
    }
    Params p{};
    const float* const* in = (const float* const*)d_in;
    p.x = in[0]; p.norm_mix_w = in[1]; p.w_in = in[2]; p.lq1 = in[3]; p.lk1 = in[4]; p.lq2 = in[5]; p.lk2 = in[6];
    p.subln_w = in[7]; p.sinks = in[8]; p.w_br_da = in[9]; p.w_br_sw = in[10]; p.w_mix_out = in[11]; p.norm_ffn_w = in[12];
    p.w_up = in[13]; p.conv_w = in[14]; p.conv_b = in[15]; p.w_down = in[16]; p.norm_final_w = in[17];
    p.out = (float*)d_out;
    p.ws = (char*)d_ws;
    if (ws_size < WS_TOTAL) { fprintf(stderr, "workspace too small: %zu < %zu\n", ws_size, (size_t)WS_TOTAL); return; }
#ifndef MULTI_LAUNCH
#define MULTI_LAUNCH 0
#endif
#if MULTI_LAUNCH
    for (int ph = 0; ph < 2 + 6 * DEPTH; ++ph) mega_kernel<<<dim3(grid_blocks), dim3(NTHR), 0, stream>>>(p, ph, ph + 1, 0);
#else
    int lo = 0, hi = 1000, us = 1;
    void* args[] = {&p, &lo, &hi, &us};
    hipMemsetAsync((char*)d_ws + OFF_BAR, 0, XCD_BAR_WORDS * 4, stream);
    hipError_t e = hipLaunchCooperativeKernel((void*)mega_kernel, dim3(grid_blocks), dim3(NTHR), args, 0, stream);
    if (e != hipSuccess) fprintf(stderr, "cooperative launch failed: %s (grid %d)\n", hipGetErrorString(e), grid_blocks);
#endif
}
```

```cpp
#include <hip/hip_runtime.h>
#include <hip/hip_cooperative_groups.h>
#include <cstdio>
namespace cg = cooperative_groups;

typedef unsigned short bf16_t;
typedef short bf16x8 __attribute__((ext_vector_type(8)));
typedef float f32x16 __attribute__((ext_vector_type(16)));
typedef float f32x4 __attribute__((ext_vector_type(4)));
typedef unsigned u32x4 __attribute__((ext_vector_type(4)));
typedef unsigned u32x2 __attribute__((ext_vector_type(2)));

#define DEVI __device__ __forceinline__

constexpr int DM = 1024, NTOK = 16384, SEQ = 4096, DEPTH = 4;
constexpr int INC = 4352, DFF = 2816, DFF2 = 5632;
constexpr float EPS = 1e-6f;
constexpr float LOG2E = 1.4426950408889634f;
constexpr float QSCALE = 0.125f * LOG2E;

constexpr size_t SZ_WT_IN = (size_t)INC * DM * 2, SZ_WT_BR = (size_t)DM * 512 * 2, SZ_WT_MIX = (size_t)DM * DM * 2,
                 SZ_WT_UP = (size_t)DFF2 * DM * 2, SZ_WT_DN = (size_t)DM * DFF * 2;
constexpr size_t OFF_WT_IN = 0;
constexpr size_t OFF_WT_DA = OFF_WT_IN + DEPTH * SZ_WT_IN;
constexpr size_t OFF_WT_SW = OFF_WT_DA + DEPTH * SZ_WT_BR;
constexpr size_t OFF_WT_MIX = OFF_WT_SW + DEPTH * SZ_WT_BR;
constexpr size_t OFF_WT_UP = OFF_WT_MIX + DEPTH * SZ_WT_MIX;
constexpr size_t OFF_WT_DN = OFF_WT_UP + DEPTH * SZ_WT_UP;
constexpr size_t OFF_XB = OFF_WT_DN + DEPTH * SZ_WT_DN;
constexpr size_t OFF_SSQ_MIX = OFF_XB + (size_t)NTOK * DM * 2;
constexpr size_t OFF_SSQ_FFN = OFF_SSQ_MIX + (size_t)NTOK * 16 * 4;
constexpr size_t OFF_CTR = OFF_SSQ_FFN + (size_t)NTOK * 16 * 4;
constexpr size_t OFF_QKDA = OFF_CTR + 256;
constexpr size_t OFF_VTDA = OFF_QKDA + (size_t)NTOK * 1024 * 2;
constexpr size_t OFF_QSW = OFF_VTDA + (size_t)NTOK * 512 * 2;
constexpr size_t OFF_KSW = OFF_QSW + (size_t)NTOK * 512 * 2;
constexpr size_t OFF_VTSW = OFF_KSW + (size_t)NTOK * 128 * 2;
constexpr size_t OFF_GATES = OFF_VTSW + (size_t)NTOK * 128 * 2;
constexpr size_t OFF_Y = OFF_GATES + (size_t)NTOK * 2048 * 2;
constexpr size_t OFF_BAR = OFF_Y + (size_t)NTOK * 1024 * 2;
constexpr size_t WS_TOTAL = OFF_BAR + 16384;

struct Params {
    const float *x, *norm_mix_w, *w_in, *lq1, *lk1, *lq2, *lk2, *subln_w, *sinks, *w_br_da, *w_br_sw, *w_mix_out,
        *norm_ffn_w, *w_up, *conv_w, *conv_b, *w_down, *norm_final_w;
    float* out;
    char* ws;
};

constexpr int NTHR = 512;
constexpr int RSTD_OFF = 147456;
constexpr int SMEM_BYTES = 147456 + 2048;

typedef __bf16 bf16v2 __attribute__((ext_vector_type(2)));
typedef float f32x2 __attribute__((ext_vector_type(2)));
DEVI unsigned pk_bf16(float lo, float hi) {
    bf16v2 r = __builtin_convertvector((f32x2){lo, hi}, bf16v2);
    return __builtin_bit_cast(unsigned, r);
}
DEVI float bf2f_lo(unsigned u) { return __uint_as_float(u << 16); }
DEVI float bf2f_hi(unsigned u) { return __uint_as_float(u & 0xffff0000u); }
DEVI float fast_sigmoid(float x) { return __builtin_amdgcn_rcpf(1.0f + __builtin_amdgcn_exp2f(-x * LOG2E)); }
DEVI float sum_halves(float v) {
    u32x2 r = __builtin_amdgcn_permlane32_swap(__float_as_uint(v), __float_as_uint(v), false, false);
    return __uint_as_float(r[0]) + __uint_as_float(r[1]);
}
DEVI float max_halves(float v) {
    u32x2 r = __builtin_amdgcn_permlane32_swap(__float_as_uint(v), __float_as_uint(v), false, false);
    return fmaxf(__uint_as_float(r[0]), __uint_as_float(r[1]));
}
DEVI float row_ssq(const float* __restrict__ ssq, int tok) {
    const f32x4 a = *(const f32x4*)(ssq + (size_t)tok * 16), b = *(const f32x4*)(ssq + (size_t)tok * 16 + 4),
                c = *(const f32x4*)(ssq + (size_t)tok * 16 + 8), d = *(const f32x4*)(ssq + (size_t)tok * 16 + 12);
    return ((a[0] + a[1]) + (a[2] + a[3])) + ((b[0] + b[1]) + (b[2] + b[3])) + ((c[0] + c[1]) + (c[2] + c[3])) + ((d[0] + d[1]) + (d[2] + d[3]));
}
DEVI int opaque_tid() { int t = threadIdx.x; asm volatile("" : "+v"(t)); return t; }

__device__ __forceinline__ void convert_weights(const Params& p, char* smem, int l_lo, int l_hi, int vb, int nvb) {
    const int tid = opaque_tid();
    const int half = tid >> 8, ht = tid & 255;
    float* T = (float*)smem + half * (64 * 65);
    const int total = (l_hi - l_lo) * 3712;
    const int iters = (total + 2 * nvb - 1) / (2 * nvb);
    for (int it = 0; it < iters; ++it) {
        const int t = (it * nvb + vb) * 2 + half;
        const bool act = t < total;
        const int l = l_lo + (act ? t / 3712 : 0);
        int r = act ? t % 3712 : 0;
        const float* W;
        const float* sc = nullptr;
        bf16_t* D;
        int K, N, mode = 0, scmask = 0x7fffffff;
        float scmul = 1.0f;
        if (r < 1088) {
            W = p.w_in + (size_t)l * DM * INC; K = DM; N = INC; sc = p.norm_mix_w + l * DM;
            D = (bf16_t*)(p.ws + OFF_WT_IN + l * SZ_WT_IN);
        } else if ((r -= 1088) < 128) {
            W = p.w_br_da + (size_t)l * 512 * DM; K = 512; N = DM; D = (bf16_t*)(p.ws + OFF_WT_DA + l * SZ_WT_BR);
            sc = p.subln_w + l * 128; scmask = 127; scmul = 1.0f - (0.8f - 0.6f * expf(-0.3f * (float)l));
        } else if ((r -= 128) < 128) {
            W = p.w_br_sw + (size_t)l * 512 * DM; K = 512; N = DM; D = (bf16_t*)(p.ws + OFF_WT_SW + l * SZ_WT_BR);
        } else if ((r -= 128) < 256) {
            W = p.w_mix_out + (size_t)l * DM * DM; K = DM; N = DM; D = (bf16_t*)(p.ws + OFF_WT_MIX + l * SZ_WT_MIX);
        } else if ((r -= 256) < 1408) {
            W = p.w_up + (size_t)l * DM * DFF2; K = DM; N = DFF2; sc = p.norm_ffn_w + l * DM; mode = 1;
            D = (bf16_t*)(p.ws + OFF_WT_UP + l * SZ_WT_UP);
        } else {
            r -= 1408;
            W = p.w_down + (size_t)l * DFF * DM; K = DFF; N = DM; D = (bf16_t*)(p.ws + OFF_WT_DN + l * SZ_WT_DN);
        }
        const int ntn = N >> 6;
        const int k0 = (r / ntn) * 64, n0 = (r % ntn) * 64;
        __syncthreads();
        if (act) {
#pragma unroll
            for (int i = 0; i < 4; ++i) {
                const int kr = (ht >> 4) + 16 * i, c4 = (ht & 15) * 4;
                f32x4 v = *(const f32x4*)(W + (size_t)(k0 + kr) * N + n0 + c4);
                const float s_ = sc ? sc[(k0 + kr) & scmask] * scmul : 1.0f;
                T[kr * 65 + c4 + 0] = v[0] * s_; T[kr * 65 + c4 + 1] = v[1] * s_;
                T[kr * 65 + c4 + 2] = v[2] * s_; T[kr * 65 + c4 + 3] = v[3] * s_;
            }
        }
        __syncthreads();
        if (act) {
            const int nl = ht >> 2, kc = (ht & 3) * 16;
            int n = n0 + nl;
            if (mode == 1) n = (n < DFF) ? ((n >> 7) * 256 + (n & 127)) : (((n - DFF) >> 7) * 256 + 128 + ((n - DFF) & 127));
            unsigned o[8];
#pragma unroll
            for (int e = 0; e < 8; ++e) o[e] = pk_bf16(T[(kc + 2 * e) * 65 + nl], T[(kc + 2 * e + 1) * 65 + nl]);
            bf16_t* dst = D + (size_t)n * K + k0 + kc;
            *(u32x4*)dst = (u32x4){o[0], o[1], o[2], o[3]};
            *(u32x4*)(dst + 8) = (u32x4){o[4], o[5], o[6], o[7]};
        }
    }
}

__device__ __forceinline__ void phase_convert(const Params& p, char* smem) {
    convert_weights(p, smem, 0, 1, blockIdx.x, gridDim.x);
    const int tid = opaque_tid();
    {
        const int lane = tid & 63, wave = tid >> 6;
        bf16_t* XB = (bf16_t*)(p.ws + OFF_XB);
        float* ssq = (float*)(p.ws + OFF_SSQ_MIX);
        const int wstride = gridDim.x * 8;
        for (int row0 = blockIdx.x * 8 + wave; row0 < NTOK; row0 += 4 * wstride) {
            f32x4 v[4][4];
#pragma unroll
            for (int rr = 0; rr < 4; ++rr) {
                const int row = row0 + rr * wstride;
                if (row < NTOK) {
#pragma unroll
                    for (int i = 0; i < 4; ++i) v[rr][i] = *(const f32x4*)(p.x + (size_t)row * DM + i * 256 + lane * 4);
                }
            }
#pragma unroll
            for (int rr = 0; rr < 4; ++rr) {
                const int row = row0 + rr * wstride;
                if (row < NTOK) {
                    float s = 0.f;
#pragma unroll
                    for (int i = 0; i < 4; ++i) {
                        s += v[rr][i][0] * v[rr][i][0] + v[rr][i][1] * v[rr][i][1] + v[rr][i][2] * v[rr][i][2] + v[rr][i][3] * v[rr][i][3];
                        *(u32x2*)(XB + (size_t)row * DM + i * 256 + lane * 4) = (u32x2){pk_bf16(v[rr][i][0], v[rr][i][1]), pk_bf16(v[rr][i][2], v[rr][i][3])};
                    }
#pragma unroll
                    for (int o = 32; o >= 1; o >>= 1) s += __shfl_xor(s, o, 64);
                    if (lane < 16) ssq[(size_t)row * 16 + lane] = (lane == 0) ? s : 0.f;
                }
            }
        }
    }
}

DEVI int virt_block() { return (blockIdx.x & 7) * (gridDim.x >> 3) + (blockIdx.x >> 3); }
DEVI void tile_order(int t, int MT, int NT, int& mt, int& nt) {
    const int grp = t / (8 * NT);
    const int first = grp * 8;
    const int gsz = (MT - first) < 8 ? (MT - first) : 8;
    const int rem = t - grp * 8 * NT;
    mt = first + rem % gsz;
    nt = rem / gsz;
}

namespace pg8 {
#define PG8_LAS __attribute__((address_space(3)))
constexpr int BM = 256, BK = 64, HALF = 128, HTB = HALF * BK * 2  , STAGE_BYTES = 8 * HTB, NXCD = 8, WGM = 8;

__host__ __device__ __forceinline__ int lds_byte(int r, int c) { const int st = (r >> 4) * 2 + (c >> 5), rr = r & 15, cc = c & 31, ob = rr * 64 + cc * 2; return st * 1024 + (ob ^ (((ob >> 9) & 1) << 5)); }
__host__ __device__ __forceinline__ void stage_rc(int b, int& R, int& C) { const int st = b / 1024, sb = b % 1024, swz = sb ^ (((sb >> 9) & 1) << 5); R = (st >> 1) * 16 + swz / 64; C = (st & 1) * 32 + (swz % 64) / 2; }
__host__ __device__ __forceinline__ int perm32(int rho) { const int n = rho >> 4, i = rho & 15; return 8 * (i >> 2) + 4 * n + (i & 3); }
struct Unit { int pm, pn, idx; };
struct Gemm { const bf16_t* A; const bf16_t* Bt; int M, N, K; };
template <class Epi, class Sched, bool ALIGN_EPI = false, bool SP2 = false>
__device__ __forceinline__ void gemm_phase(PG8_LAS unsigned char* lds, const Gemm g, const Sched& S, const Epi& E) {
    const int tid = opaque_tid(), wid = __builtin_amdgcn_readfirstlane(tid >> 6), lane = tid & 63, wr = wid >> 2, wc = wid & 3, fr = lane & 15, fq = lane >> 4;
    const int K = g.K, nt = K / BK;
    unsigned voffA[2], voffB[2];
#pragma unroll
    for (int i = 0; i < 2; ++i) { int R, C; stage_rc(tid * 16 + i * 8192, R, C); const int Rb = Epi::PERM ? ((R & ~31) + perm32(R & 31)) : R;
        voffA[i] = (unsigned)(R * K + C) * 2u; voffB[i] = (unsigned)(Rb * K + C) * 2u; }
    const size_t kstep = (size_t)(BK * 2);
    const size_t hstep = (size_t)HALF * K * 2;
    const size_t tstep = 2 * hstep;
    const unsigned ldsw = (unsigned)wid * 1024u;
    const int aoff = lds_byte(wr * 64 + fr, fq * 8), boff = lds_byte(wc * 32 + fr, fq * 8);
#define PG8_SA(b, h) (((b) * 2 + (h)) * HTB)
#define PG8_SB(b, h) ((4 + (b) * 2 + (h)) * HTB)
#define PG8_STAGE(bufoff, gbase, voff) do { _Pragma("unroll") for (int _i = 0; _i < 2; ++_i) \
        __builtin_amdgcn_global_load_lds((const unsigned*)((const char*)(gbase) + (voff)[_i]), (PG8_LAS unsigned*)(lds + (bufoff) + ldsw + _i * 8192), 16, 0, 0); } while (0)
#define PG8_LDA(dst, b, h) do { _Pragma("unroll") for (int m = 0; m < 4; ++m) _Pragma("unroll") for (int k = 0; k < 2; ++k) dst[m][k] = *(const PG8_LAS bf16x8*)(lds + PG8_SA(b, h) + aoff + m * 2048 + k * 1024); } while (0)
#define PG8_LDB(dst, b, h) do { _Pragma("unroll") for (int n = 0; n < 2; ++n) _Pragma("unroll") for (int k = 0; k < 2; ++k) dst[n][k] = *(const PG8_LAS bf16x8*)(lds + PG8_SB(b, h) + boff + n * 2048 + k * 1024); } while (0)
#define PG8_MMA(ai, bj, At, Bt) do { __builtin_amdgcn_s_setprio(1); _Pragma("unroll") for (int m = 0; m < 4; ++m) _Pragma("unroll") for (int n = 0; n < 2; ++n) _Pragma("unroll") for (int k = 0; k < 2; ++k) \
        acc[ai][bj][m][n] = __builtin_amdgcn_mfma_f32_16x16x32_bf16(Bt[n][k], At[m][k], acc[ai][bj][m][n], 0, 0, 0); __builtin_amdgcn_s_setprio(0); } while (0)
#define PG8_WAIT_V(n) asm volatile("s_waitcnt vmcnt(" #n ")" ::: "memory")
#define PG8_WAIT_L(n) asm volatile("s_waitcnt lgkmcnt(" #n ")" ::: "memory")
#define PG8_BAR __builtin_amdgcn_s_barrier()
#define PG8_SCHED __builtin_amdgcn_sched_barrier(0)
    Unit cur, nxt; int ui = 0;
    if (!S.next(0, cur)) return;
    f32x4 acc[2][2][4][2];
#pragma unroll
    for (int a = 0; a < 2; ++a)
#pragma unroll
        for (int b = 0; b < 2; ++b)
#pragma unroll
            for (int m = 0; m < 4; ++m)
#pragma unroll
                for (int n = 0; n < 2; ++n) acc[a][b][m][n] = (f32x4){0.f, 0.f, 0.f, 0.f};
    bf16x8 At[4][2], B0[2][2], B1[2][2];
    const char* cA = S.a_ptr(g, cur); const char* cB = S.b_ptr(g, cur);
    S.a_ready(cur);
    if constexpr (SP2) {
        PG8_STAGE(PG8_SB(0, 0), cB, voffB); PG8_STAGE(PG8_SB(0, 1), cB + hstep, voffB); PG8_STAGE(PG8_SA(0, 0), cA, voffA); PG8_STAGE(PG8_SA(0, 1), cA + hstep, voffA);
        if (wr == 1) PG8_BAR;
        PG8_WAIT_V(2); PG8_BAR;
        PG8_STAGE(PG8_SB(1, 0), cB + kstep, voffB); PG8_STAGE(PG8_SA(1, 0), cA + kstep, voffA); PG8_STAGE(PG8_SB(1, 1), cB + hstep + kstep, voffB);
        PG8_WAIT_V(6); PG8_BAR;
    } else {
        PG8_STAGE(PG8_SB(0, 0), cB, voffB); PG8_STAGE(PG8_SA(0, 0), cA, voffA); PG8_STAGE(PG8_SB(0, 1), cB + hstep, voffB); PG8_STAGE(PG8_SA(0, 1), cA + hstep, voffA);
        if (wr == 1) PG8_BAR;
        PG8_WAIT_V(4); PG8_BAR;
        PG8_STAGE(PG8_SB(1, 0), cB + kstep, voffB); PG8_STAGE(PG8_SA(1, 0), cA + kstep, voffA); PG8_STAGE(PG8_SB(1, 1), cB + hstep + kstep, voffB);
        PG8_WAIT_V(6); PG8_BAR;
    }
    for (;;) {
        const bool has_next = S.next(ui + 1, nxt);
        const char* nA = has_next ? S.a_ptr(g, nxt) : cA; const char* nB = has_next ? S.b_ptr(g, nxt) : cB;
        for (int t = 0; t < nt; t += 2) {
            const bool last = (t == nt - 2);
            const char* a1 = cA + (size_t)(t + 1) * kstep;
            const char* a2 = last ? nA : cA + (size_t)(t + 2) * kstep; const char* b2 = last ? nB : cB + (size_t)(t + 2) * kstep;
            const char* a3 = a2 + kstep; const char* b3 = b2 + kstep;
            if (last && has_next) S.a_ready(nxt);
            if constexpr (SP2) {
            PG8_LDB(B0, 0, 0); PG8_LDB(B1, 0, 1); PG8_SCHED; PG8_LDA(At, 0, 0); PG8_STAGE(PG8_SA(1, 1), a1 + hstep, voffA);
            PG8_WAIT_V(8); PG8_WAIT_L(0); PG8_BAR; PG8_MMA(0, 0, At, B0); PG8_MMA(0, 1, At, B1); PG8_BAR; PG8_SCHED;
            PG8_LDA(At, 0, 1); PG8_STAGE(PG8_SB(0, 0), b2, voffB); PG8_STAGE(PG8_SB(0, 1), b2 + hstep, voffB); PG8_STAGE(PG8_SA(0, 0), a2, voffA);
            PG8_WAIT_V(8); PG8_WAIT_L(0); PG8_BAR; PG8_MMA(1, 0, At, B0); PG8_MMA(1, 1, At, B1); PG8_BAR; PG8_SCHED;
            PG8_LDB(B0, 1, 0); PG8_LDB(B1, 1, 1); PG8_SCHED; PG8_LDA(At, 1, 0); PG8_STAGE(PG8_SA(0, 1), a2 + hstep, voffA);
            PG8_WAIT_V(8); PG8_WAIT_L(0); PG8_BAR; PG8_MMA(0, 0, At, B0); PG8_MMA(0, 1, At, B1); PG8_BAR; PG8_SCHED;
            PG8_LDA(At, 1, 1); PG8_STAGE(PG8_SB(1, 0), b3, voffB); PG8_STAGE(PG8_SB(1, 1), b3 + hstep, voffB); PG8_STAGE(PG8_SA(1, 0), a3, voffA);
            PG8_WAIT_V(8); PG8_WAIT_L(0); PG8_BAR; PG8_MMA(1, 0, At, B0); PG8_MMA(1, 1, At, B1); PG8_BAR; PG8_SCHED;
            } else {
            PG8_LDB(B0, 0, 0); PG8_SCHED; PG8_LDA(At, 0, 0); PG8_STAGE(PG8_SA(1, 1), a1 + hstep, voffA);
            PG8_WAIT_L(8); PG8_BAR; PG8_WAIT_L(0); PG8_MMA(0, 0, At, B0); PG8_BAR; PG8_SCHED;
            PG8_LDB(B1, 0, 1); PG8_STAGE(PG8_SB(0, 0), b2, voffB);
            PG8_BAR; PG8_WAIT_L(0); PG8_MMA(0, 1, At, B1); PG8_BAR;
            PG8_LDA(At, 0, 1); PG8_STAGE(PG8_SA(0, 0), a2, voffA);
            PG8_BAR; PG8_WAIT_L(0); PG8_MMA(1, 0, At, B0); PG8_BAR; PG8_SCHED;
            PG8_STAGE(PG8_SB(0, 1), b2 + hstep, voffB);
            PG8_WAIT_V(6); PG8_BAR; PG8_MMA(1, 1, At, B1); PG8_BAR;
            PG8_LDB(B0, 1, 0); PG8_SCHED; PG8_LDA(At, 1, 0); PG8_STAGE(PG8_SA(0, 1), a2 + hstep, voffA);
            PG8_WAIT_L(8); PG8_BAR; PG8_WAIT_L(0); PG8_MMA(0, 0, At, B0); PG8_BAR; PG8_SCHED;
            PG8_LDB(B1, 1, 1); PG8_STAGE(PG8_SB(1, 0), b3, voffB);
            PG8_BAR; PG8_WAIT_L(0); PG8_MMA(0, 1, At, B1); PG8_BAR;
            PG8_LDA(At, 1, 1); PG8_STAGE(PG8_SA(1, 0), a3, voffA);
            PG8_BAR; PG8_WAIT_L(0); PG8_MMA(1, 0, At, B0); PG8_BAR; PG8_SCHED;
            PG8_STAGE(PG8_SB(1, 1), b3 + hstep, voffB);
            PG8_WAIT_V(6); PG8_BAR; PG8_MMA(1, 1, At, B1); PG8_BAR;
            }
        }
        if constexpr (ALIGN_EPI) { if (wr == 0) PG8_BAR; }
        if constexpr (!Epi::AFTER_DRAIN) { E(acc, cur, wr, wc, fr, fq); S.done(cur); }
        if (!has_next) break;
        if (!S.keep(nxt)) {
#pragma unroll
        for (int a = 0; a < 2; ++a)
#pragma unroll
            for (int b = 0; b < 2; ++b)
#pragma unroll
                for (int m = 0; m < 4; ++m)
#pragma unroll
                    for (int n = 0; n < 2; ++n) acc[a][b][m][n] = (f32x4){0.f, 0.f, 0.f, 0.f};
        }
        cur = nxt; cA = nA; cB = nB; ++ui;
        if constexpr (ALIGN_EPI) { if (wr == 1) PG8_BAR; }
    }
    PG8_WAIT_V(0);
    if constexpr (!ALIGN_EPI) { if (wr == 0) PG8_BAR; }
    PG8_BAR;
    if constexpr (Epi::AFTER_DRAIN) { E.fused(acc, cur, wr, wc, fr, fq, lds, wid, lane); S.done(cur); }
#undef PG8_SA
#undef PG8_SB
#undef PG8_STAGE
#undef PG8_LDA
#undef PG8_LDB
#undef PG8_MMA
#undef PG8_WAIT_V
#undef PG8_WAIT_L
#undef PG8_BAR
#undef PG8_SCHED
}
}

struct TileSched {
    int MT, NT, vb, G;
    DEVI bool next(int i, pg8::Unit& u) const {
        const int t = i * G + vb;
        if (t >= MT * NT) return false;
        tile_order(t, MT, NT, u.pm, u.pn);
        u.idx = i;
        return true;
    }
    DEVI const char* a_ptr(const pg8::Gemm& g, const pg8::Unit& u) const { return (const char*)g.A + (size_t)u.pm * 256 * g.K * 2; }
    DEVI const char* b_ptr(const pg8::Gemm& g, const pg8::Unit& u) const { return (const char*)g.Bt + (size_t)u.pn * 256 * g.K * 2; }
    DEVI bool keep(const pg8::Unit&) const { return false; }
    DEVI void a_ready(const pg8::Unit&) const {}
    DEVI void done(const pg8::Unit&) const {}
};
struct BranchSched {
    int pm, pn; const bf16_t *A1, *A2, *B1, *B2;
    DEVI bool next(int i, pg8::Unit& u) const { if (i > 1) return false; u.pm = pm; u.pn = pn; u.idx = i; return true; }
    DEVI const char* a_ptr(const pg8::Gemm& g, const pg8::Unit& u) const { return (const char*)(u.idx ? A2 : A1) + (size_t)u.pm * 256 * g.K * 2; }
    DEVI const char* b_ptr(const pg8::Gemm& g, const pg8::Unit& u) const { return (const char*)(u.idx ? B2 : B1) + (size_t)u.pn * 256 * g.K * 2; }
    DEVI bool keep(const pg8::Unit& u) const { return u.idx == 1; }
    DEVI void a_ready(const pg8::Unit&) const {}
    DEVI void done(const pg8::Unit&) const {}
};
struct OneUnit {
    pg8::Unit u; long a_row0;
    DEVI bool next(int i, pg8::Unit& o) const { if (i) return false; o = u; return true; }
    DEVI const char* a_ptr(const pg8::Gemm& g, const pg8::Unit&) const { return (const char*)g.A + a_row0 * (long)g.K * 2; }
    DEVI const char* b_ptr(const pg8::Gemm& g, const pg8::Unit& o) const { return (const char*)g.Bt + (size_t)o.pn * 256 * g.K * 2; }
    DEVI bool keep(const pg8::Unit&) const { return false; }
    DEVI void a_ready(const pg8::Unit&) const {}
    DEVI void done(const pg8::Unit&) const {}
};
typedef const __attribute__((address_space(3))) float* lds_cfptr;

struct EpiInproj {
    static constexpr bool PERM = true, AFTER_DRAIN = false;
    char* ws; lds_cfptr rstd_all;
    DEVI void operator()(const f32x4 (&acc)[2][2][4][2], const pg8::Unit& u, int wr, int wc, int fr, int fq) const {
        lds_cfptr rs_u = rstd_all + u.idx * 256;
        const int m0 = u.pm * 256;
#pragma unroll
        for (int bj = 0; bj < 2; ++bj) {
            const int cb = u.pn * 256 + bj * 128 + wc * 32;
            const bool isv = (cb >= 1024 && cb < 1536) || (cb >= 2176 && cb < 2304);
            if (!isv) {
                bf16_t* dst; int ld, coff, mode;
                if (cb < 512) { dst = (bf16_t*)(ws + OFF_QKDA); ld = 1024; coff = cb; mode = 0; }
                else if (cb < 1024) { dst = (bf16_t*)(ws + OFF_QKDA); ld = 1024; coff = cb; mode = 1; }
                else if (cb < 2048) { dst = (bf16_t*)(ws + OFF_QSW); ld = 512; coff = cb - 1536; mode = 0; }
                else if (cb < 2176) { dst = (bf16_t*)(ws + OFF_KSW); ld = 128; coff = cb - 2048; mode = 1; }
                else { dst = (bf16_t*)(ws + OFF_GATES); ld = 2048; coff = cb - 2304; mode = 2; }
#pragma unroll
                for (int ai = 0; ai < 2; ++ai)
#pragma unroll
                    for (int m = 0; m < 4; ++m) {
                        const int rl = ai * 128 + wr * 64 + m * 16 + fr;
                        float rs = rs_u[rl];
                        if (mode == 0) rs *= QSCALE;
                        f32x4 v0 = acc[ai][bj][m][0] * rs, v1 = acc[ai][bj][m][1] * rs;
                        if (mode == 2) {
#pragma unroll
                            for (int e = 0; e < 4; ++e) { v0[e] = fast_sigmoid(v0[e]); v1[e] = fast_sigmoid(v1[e]); }
                        }
                        *(u32x4*)(dst + (size_t)(m0 + rl) * ld + coff + fq * 8) =
                            (u32x4){pk_bf16(v0[0], v0[1]), pk_bf16(v0[2], v0[3]), pk_bf16(v1[0], v1[1]), pk_bf16(v1[2], v1[3])};
                    }
            } else {
                bf16_t* dst; int rowbase, rows_per_b;
                const int b = m0 >> 12, s0 = m0 & 4095;
                if (cb < 1536) { dst = (bf16_t*)(ws + OFF_VTDA); rowbase = cb - 1024; rows_per_b = 512; }
                else { dst = (bf16_t*)(ws + OFF_VTSW); rowbase = cb - 2176; rows_per_b = 128; }
#pragma unroll
                for (int ai = 0; ai < 2; ++ai)
#pragma unroll
                    for (int m = 0; m < 4; ++m) {
                        const int rl = ai * 128 + wr * 64 + m * 16 + fr;
                        const float rs = rs_u[rl];
                        bf16_t* d = dst + (size_t)(b * rows_per_b + rowbase + fq * 8) * SEQ + s0 + rl;
#pragma unroll
                        for (int n = 0; n < 2; ++n)
#pragma unroll
                            for (int e = 0; e < 4; e += 2) {
                                const unsigned pk = pk_bf16(acc[ai][bj][m][n][e] * rs, acc[ai][bj][m][n][e + 1] * rs);
                                d[(size_t)(4 * n + e) * SEQ] = (bf16_t)(pk & 0xffffu);
                                d[(size_t)(4 * n + e + 1) * SEQ] = (bf16_t)(pk >> 16);
                            }
                    }
            }
        }
    }
};

struct EpiBranch {
    static constexpr bool PERM = true, AFTER_DRAIN = false;
    char* ws;
    DEVI void operator()(f32x4 (&acc)[2][2][4][2], const pg8::Unit& u, int wr, int wc, int fr, int fq) const {
        asm volatile("" : "+v"(fr), "+v"(fq));
        const bf16_t* G = (const bf16_t*)(ws + OFF_GATES);
        bf16_t* MG = (bf16_t*)(ws + OFF_QKDA);
        const int m0 = u.pm * 256, c0 = u.pn * 256 + wc * 32 + fq * 8;
        if (u.idx == 0) {
#pragma unroll
            for (int am = 0; am < 8; ++am) {
                const int ai = am >> 2, m = am & 3;
                u32x4 g1[2], g2[2];
#pragma unroll
                for (int bj = 0; bj < 2; ++bj) {
                    const bf16_t* gp = G + (size_t)(m0 + ai * 128 + wr * 64 + m * 16 + fr) * 2048 + c0 + bj * 128;
                    g1[bj] = *(const u32x4*)gp;
                    g2[bj] = *(const u32x4*)(gp + 1024);
                }
#pragma unroll
                for (int bj = 0; bj < 2; ++bj)
#pragma unroll
                    for (int n = 0; n < 2; ++n) {
                        const unsigned a = g1[bj][2 * n], b = g1[bj][2 * n + 1], c = g2[bj][2 * n], d = g2[bj][2 * n + 1];
                        acc[ai][bj][m][n][0] *= bf2f_lo(a) * __builtin_amdgcn_rcpf(bf2f_lo(c));
                        acc[ai][bj][m][n][1] *= bf2f_hi(a) * __builtin_amdgcn_rcpf(bf2f_hi(c));
                        acc[ai][bj][m][n][2] *= bf2f_lo(b) * __builtin_amdgcn_rcpf(bf2f_lo(d));
                        acc[ai][bj][m][n][3] *= bf2f_hi(b) * __builtin_amdgcn_rcpf(bf2f_hi(d));
                    }
                __builtin_amdgcn_sched_barrier(0);
            }
        } else {
#pragma unroll
            for (int am = 0; am < 8; ++am) {
                const int ai = am >> 2, m = am & 3;
                u32x4 g2[2];
#pragma unroll
                for (int bj = 0; bj < 2; ++bj) g2[bj] = *(const u32x4*)(G + (size_t)(m0 + ai * 128 + wr * 64 + m * 16 + fr) * 2048 + 1024 + c0 + bj * 128);
#pragma unroll
                for (int bj = 0; bj < 2; ++bj) {
                    const u32x4 gg = g2[bj];
                    const f32x4 a0 = acc[ai][bj][m][0], a1 = acc[ai][bj][m][1];
                    *(u32x4*)(MG + (size_t)(m0 + ai * 128 + wr * 64 + m * 16 + fr) * 1024 + c0 + bj * 128) =
                        (u32x4){pk_bf16(a0[0] * bf2f_lo(gg[0]), a0[1] * bf2f_hi(gg[0])), pk_bf16(a0[2] * bf2f_lo(gg[1]), a0[3] * bf2f_hi(gg[1])),
                                pk_bf16(a1[0] * bf2f_lo(gg[2]), a1[1] * bf2f_hi(gg[2])), pk_bf16(a1[2] * bf2f_lo(gg[3]), a1[3] * bf2f_hi(gg[3]))};
                }
                if (am & 1) __builtin_amdgcn_sched_barrier(0);
            }
        }
    }
};

struct EpiResid {
    static constexpr bool PERM = true, AFTER_DRAIN = false;
    char* ws; const float* xold; float* ssq;
    DEVI void operator()(const f32x4 (&acc)[2][2][4][2], const pg8::Unit& u, int wr, int wc, int fr, int fq) const {
        bf16_t* XB = (bf16_t*)(ws + OFF_XB);
        const int m0 = u.pm * 256, c0 = u.pn * 256 + wc * 32 + fq * 8;
#pragma unroll
        for (int ai = 0; ai < 2; ++ai) {
            u32x4 xo[4][2];
            if (!xold) {
#pragma unroll
                for (int m = 0; m < 4; ++m)
#pragma unroll
                    for (int bj = 0; bj < 2; ++bj) xo[m][bj] = *(const u32x4*)(XB + (size_t)(m0 + ai * 128 + wr * 64 + m * 16 + fr) * DM + c0 + bj * 128);
            }
#pragma unroll
            for (int m = 0; m < 4; ++m) {
                const int tok = m0 + ai * 128 + wr * 64 + m * 16 + fr;
                float sq = 0.f;
#pragma unroll
                for (int bj = 0; bj < 2; ++bj) {
                    f32x4 a0, a1;
                    if (xold) { a0 = *(const f32x4*)(xold + (size_t)tok * DM + c0 + bj * 128); a1 = *(const f32x4*)(xold + (size_t)tok * DM + c0 + bj * 128 + 4); }
                    else {
                        const u32x4 w = xo[m][bj];
                        a0 = (f32x4){bf2f_lo(w[0]), bf2f_hi(w[0]), bf2f_lo(w[1]), bf2f_hi(w[1])};
                        a1 = (f32x4){bf2f_lo(w[2]), bf2f_hi(w[2]), bf2f_lo(w[3]), bf2f_hi(w[3])};
                    }
                    a0 += acc[ai][bj][m][0]; a1 += acc[ai][bj][m][1];
                    sq += a0[0] * a0[0] + a0[1] * a0[1] + a0[2] * a0[2] + a0[3] * a0[3] + a1[0] * a1[0] + a1[1] * a1[1] + a1[2] * a1[2] + a1[3] * a1[3];
                    *(u32x4*)(XB + (size_t)tok * DM + c0 + bj * 128) = (u32x4){pk_bf16(a0[0], a0[1]), pk_bf16(a0[2], a0[3]), pk_bf16(a1[0], a1[1]), pk_bf16(a1[2], a1[3])};
                }
                sq += __shfl_xor(sq, 16, 64);
                sq = sum_halves(sq);
                if (fq == 0) ssq[(size_t)tok * 16 + u.pn * 4 + wc] = sq;
            }
        }
    }
};

constexpr int USTRB = 520;
struct EpiUp {
    static constexpr bool PERM = true, AFTER_DRAIN = true;
    char* ws; const float* cw; const float* cb; lds_cfptr rstd_s; int b, pos0, nt;
    DEVI void operator()(const f32x4 (&)[2][2][4][2], const pg8::Unit&, int, int, int, int) const {}
    DEVI void fused(const f32x4 (&acc)[2][2][4][2], const pg8::Unit&, int wr, int wc, int fr, int fq, __attribute__((address_space(3))) unsigned char* lds,
                    int, int) const {
        bf16_t* H = (bf16_t*)(ws + OFF_GATES);
        const int tid = threadIdx.x;
        const int j4 = (tid & 31) * 4, r0 = (tid >> 5) * 16;
        const int jg = nt * 128 + j4;
        f32x4 wg[3], wv[3], bg, bv;
#pragma unroll
        for (int i = 0; i < 3; ++i) { wg[i] = *(const f32x4*)(cw + i * DFF2 + jg); wv[i] = *(const f32x4*)(cw + i * DFF2 + DFF + jg); }
        bg = *(const f32x4*)(cb + jg);
        bv = *(const f32x4*)(cb + DFF + jg);
#pragma unroll
        for (int ai = 0; ai < 2; ++ai)
#pragma unroll
            for (int m = 0; m < 4; ++m) {
                const int rl = ai * 128 + wr * 64 + m * 16 + fr;
                const float rs = rstd_s[rl];
#pragma unroll
                for (int bj = 0; bj < 2; ++bj) {
                    const f32x4 v0 = acc[ai][bj][m][0] * rs, v1 = acc[ai][bj][m][1] * rs;
                    *(__attribute__((address_space(3))) u32x4*)(lds + rl * USTRB + (bj * 128 + wc * 32 + fq * 8) * 2) =
                        (u32x4){pk_bf16(v0[0], v0[1]), pk_bf16(v0[2], v0[3]), pk_bf16(v1[0], v1[1]), pk_bf16(v1[2], v1[3])};
                }
            }
        __syncthreads();
        auto ldrow = [&](int r, f32x4& ug, f32x4& uv) {
            const u32x2 a = *(const __attribute__((address_space(3))) u32x2*)(lds + r * USTRB + j4 * 2);
            const u32x2 c = *(const __attribute__((address_space(3))) u32x2*)(lds + r * USTRB + 256 + j4 * 2);
            ug = (f32x4){bf2f_lo(a[0]), bf2f_hi(a[0]), bf2f_lo(a[1]), bf2f_hi(a[1])};
            uv = (f32x4){bf2f_lo(c[0]), bf2f_hi(c[0]), bf2f_lo(c[1]), bf2f_hi(c[1])};
        };
        f32x4 g2, v2, g1, v1;
        ldrow(r0 >= 2 ? r0 - 2 : 0, g2, v2);
        ldrow(r0 >= 1 ? r0 - 1 : 0, g1, v1);
#pragma unroll 4
        for (int i = 0; i < 16; ++i) {
            const int r = r0 + i;
            f32x4 g0, v0;
            ldrow(r, g0, v0);
            const int pos = pos0 + r;
            if (r >= 2 && pos < SEQ) {
                const f32x4 cg_ = bg + g2 * wg[0] + g1 * wg[1] + g0 * wg[2];
                const f32x4 cv_ = bv + v2 * wv[0] + v1 * wv[1] + v0 * wv[2];
                f32x4 sg;
#pragma unroll
                for (int e = 0; e < 4; ++e) sg[e] = fast_sigmoid(cg_[e]);
                const f32x4 hh = cg_ * sg * cv_;
                *(u32x2*)(H + (size_t)(b * SEQ + pos) * DFF + jg) = (u32x2){pk_bf16(hh[0], hh[1]), pk_bf16(hh[2], hh[3])};
            }
            g2 = g1; v2 = v1; g1 = g0; v1 = v0;
        }
    }
};

__device__ __forceinline__ void phase_inproj(const Params& p, int l, char* smem) {
    const int tid = opaque_tid();
    const float* ssq = (const float*)(p.ws + OFF_SSQ_MIX);
    TileSched S{64, 17, virt_block(), (int)gridDim.x};
    float* rstd_all = (float*)(smem + 131072);
    for (int i = 0; i < 8; ++i) {
        pg8::Unit u;
        if (!S.next(i, u)) break;
        if (tid < 256) rstd_all[i * 256 + tid] = __builtin_amdgcn_rsqf(row_ssq(ssq, u.pm * 256 + tid) * (1.0f / DM) + EPS);
    }
    __syncthreads();
    pg8::Gemm g{(const bf16_t*)(p.ws + OFF_XB), (const bf16_t*)(p.ws + OFF_WT_IN + l * SZ_WT_IN), NTOK, INC, DM};
    EpiInproj E{p.ws, (lds_cfptr)rstd_all};
    pg8::gemm_phase<EpiInproj, TileSched, true, true>((__attribute__((address_space(3))) unsigned char*)smem, g, S, E);
    if (l + 1 < DEPTH) {
        const int ntile = 64 * 17, g_ = gridDim.x, busy = ntile % g_;
        const int vb = virt_block();
        if (busy > 0 && busy < g_) {
            if (vb >= busy) { __syncthreads(); convert_weights(p, smem, l + 1, l + 2, vb - busy, g_ - busy); }
        } else {
            __syncthreads();
            convert_weights(p, smem, l + 1, l + 2, vb, g_);
        }
    }
}

#define CJI(r) (16 * ((r) >> 3) + ((r) & 7))
template <int KROWB, int VROWB, int DV, bool SW>
DEVI void attn_sub(f32x16 (&O)[DV / 32], float& m, float& lsum, const bf16x8 (&qf)[4], const char* Ksub, const char* Vsub, int ks0, int qw,
                   int qpos, int g, float slope2) {
    constexpr int NB = DV / 32;
    const int relbase = ks0 + 8 * g - qpos;
    const float basef = slope2 * (float)relbase;
    const bool need_mask = SW || (ks0 + 31 > qw);
    bf16x8 kf[4], vf[2][NB];
#pragma unroll
    for (int kk = 0; kk < 4; ++kk) kf[kk] = *(const bf16x8*)(Ksub + kk * 32);
#pragma unroll
    for (int t = 0; t < 2; ++t)
#pragma unroll
        for (int b = 0; b < NB; ++b) vf[t][b] = *(const bf16x8*)(Vsub + b * 32 * VROWB + t * 32);
    __builtin_amdgcn_sched_barrier(0);
    f32x16 S;
#pragma unroll
    for (int r = 0; r < 16; ++r) S[r] = __builtin_fmaf(slope2, (float)CJI(r), basef);
#pragma unroll
    for (int kk = 0; kk < 4; ++kk) S = __builtin_amdgcn_mfma_f32_32x32x16_bf16(kf[kk], qf[kk], S, 0, 0, 0);
    if (need_mask) {
#pragma unroll
        for (int r = 0; r < 16; ++r) {
            const int rel = relbase + CJI(r);
            bool valid = rel <= 0;
            if (SW) valid = valid && (rel > -128) && (rel + qpos >= 0);
            S[r] = valid ? S[r] : -1e30f;
        }
    }
    float mx = S[0];
#pragma unroll
    for (int r = 1; r < 16; ++r) mx = fmaxf(mx, S[r]);
    mx = max_halves(mx);
    if (__builtin_amdgcn_ballot_w64(mx > m + 20.0f) != 0ull) {
        const float mn = fmaxf(m, mx);
        const float alpha = __builtin_amdgcn_exp2f(m - mn);
        m = mn;
        lsum *= alpha;
#pragma unroll
        for (int b = 0; b < NB; ++b)
#pragma unroll
            for (int r = 0; r < 16; ++r) O[b][r] *= alpha;
    }
    float ps = 0.f;
#pragma unroll
    for (int r = 0; r < 16; ++r) { S[r] = __builtin_amdgcn_exp2f(S[r] - m); ps += S[r]; }
    lsum += ps;
    bf16x8 P[2];
#pragma unroll
    for (int t = 0; t < 2; ++t) {
        u32x4 pk = (u32x4){pk_bf16(S[8 * t + 0], S[8 * t + 1]), pk_bf16(S[8 * t + 2], S[8 * t + 3]), pk_bf16(S[8 * t + 4], S[8 * t + 5]),
                           pk_bf16(S[8 * t + 6], S[8 * t + 7])};
        P[t] = __builtin_bit_cast(bf16x8, pk);
    }
#pragma unroll
    for (int t = 0; t < 2; ++t)
#pragma unroll
        for (int b = 0; b < NB; ++b) O[b] = __builtin_amdgcn_mfma_f32_32x32x16_bf16(vf[t][b], P[t], O[b], 0, 0, 0);
}

template <int KW, int DV, bool SW>
DEVI void attn_item(const bf16_t* __restrict__ Qp, int ldq, const bf16_t* __restrict__ Kp, int ldk, const bf16_t* __restrict__ VTp,
                    bf16_t* __restrict__ Yp, int ldy, int qw, int map, int kbeg, int kend, float slope2, float sink2, float lam, char* smem) {
    constexpr int KROWB = KW * 128 + 16;
    constexpr int VROWB = 272;
    constexpr int KCH = KW * 8;
    constexpr int NB = DV / 32;
    constexpr int KN = (128 * KCH) / NTHR, VN = (DV * 16) / NTHR;
    constexpr int ASTAGE = 128 * KROWB + DV * VROWB;
    const int tid = opaque_tid(), lane = tid & 63, q = lane & 31, g = lane >> 5, wave = __builtin_amdgcn_readfirstlane(tid >> 6);
    const int qpos = qw + q;
    bf16x8 qf[4];
#pragma unroll
    for (int kk = 0; kk < 4; ++kk) qf[kk] = *(const bf16x8*)(Qp + (size_t)qpos * ldq + map * 64 + kk * 16 + g * 8);
    f32x16 O[NB];
#pragma unroll
    for (int b = 0; b < NB; ++b)
#pragma unroll
        for (int r = 0; r < 16; ++r) O[b][r] = 0.f;
    float m = SW ? sink2 : -1e30f, lsum = (SW && g == 0) ? 1.f : 0.f;
    const int pr = (q & 0x13) | ((q & 4) << 1) | ((q & 8) >> 1);
    const int kw_off = pr * KROWB + g * 16 + map * 128;
    const int vw_off = 128 * KROWB + q * VROWB + g * 16;
    u32x4 kreg[KN], vreg[VN];
#define ATT_GLOAD(KT0)                                                                         \
    {                                                                                          \
        _Pragma("unroll") for (int i = 0; i < KN; ++i) {                                       \
            const int id = tid + NTHR * i, row = id / KCH, ch = id % KCH;                      \
            int tok = (KT0) + row;                                                             \
            tok = tok < 0 ? 0 : (tok > SEQ - 1 ? SEQ - 1 : tok);                               \
            kreg[i] = *(const u32x4*)(Kp + (size_t)tok * ldk + ch * 8);                        \
        }                                                                                      \
        _Pragma("unroll") for (int i = 0; i < VN; ++i) {                                       \
            const int id = tid + NTHR * i, r = id >> 4, ch = id & 15;                          \
            int s_ = (KT0) + ch * 8;                                                           \
            s_ = s_ < 0 ? 0 : (s_ > SEQ - 8 ? SEQ - 8 : s_);                                   \
            vreg[i] = *(const u32x4*)(VTp + (size_t)r * SEQ + s_);                             \
        }                                                                                      \
    }
#define ATT_LSTORE(BUF)                                                                        \
    {                                                                                          \
        char* D_ = smem + (BUF) * ASTAGE;                                                      \
        _Pragma("unroll") for (int i = 0; i < KN; ++i) { const int id = tid + NTHR * i, row = id / KCH, ch = id % KCH; *(u32x4*)(D_ + row * KROWB + ch * 16) = kreg[i]; } \
        _Pragma("unroll") for (int i = 0; i < VN; ++i) { const int id = tid + NTHR * i, r = id >> 4, ch = id & 15; *(u32x4*)(D_ + 128 * KROWB + r * VROWB + ch * 16) = vreg[i]; } \
    }
    int kt0 = kbeg;
    if (SW) { while (kt0 + 127 < 0) kt0 += 128; }
    ATT_GLOAD(kt0)
    __syncthreads();
    ATT_LSTORE(0)
    if (kt0 + 128 < kend) ATT_GLOAD(kt0 + 128)
    __syncthreads();
    int cur = 0;
    for (; kt0 < kend; kt0 += 128) {
        const char* St = smem + cur * ASTAGE;
#pragma unroll 1
        for (int sub = 0; sub < 4; ++sub) {
            const int ks0 = kt0 + 32 * sub;
            if (ks0 > qw + 31) break;
            if (SW && (ks0 + 31 < qw - 127 || ks0 + 31 < 0)) continue;
            attn_sub<KROWB, VROWB, DV, SW>(O, m, lsum, qf, St + kw_off + sub * 32 * KROWB, St + vw_off + sub * 64, ks0, qw, qpos, g, slope2);
        }
        if (kt0 + 128 < kend) {
            ATT_LSTORE(cur ^ 1)
            if (kt0 + 256 < kend) ATT_GLOAD(kt0 + 256)
        }
        __syncthreads();
        cur ^= 1;
    }
#undef ATT_GLOAD
#undef ATT_LSTORE
    const float lt = sum_halves(lsum);
    if (!SW) {
        __syncthreads();
        char* X = smem + (wave >> 1) * 16384;
        const float sc = (map ? lam : 1.0f) / lt;
#pragma unroll
        for (int b = 0; b < NB; ++b)
#pragma unroll
            for (int r = 0; r < 16; ++r) O[b][r] *= sc;
        if (map) {
#pragma unroll
            for (int b = 0; b < NB; ++b)
#pragma unroll
                for (int j = 0; j < 4; ++j)
                    *(f32x4*)(X + ((b * 4 + j) * 64 + lane) * 16) = (f32x4){O[b][4 * j + 0], O[b][4 * j + 1], O[b][4 * j + 2], O[b][4 * j + 3]};
        }
        __syncthreads();
        if (!map) {
            float ss = 0.f;
#pragma unroll
            for (int b = 0; b < NB; ++b)
#pragma unroll
                for (int j = 0; j < 4; ++j) {
                    const f32x4 ob = *(const f32x4*)(X + ((b * 4 + j) * 64 + lane) * 16);
#pragma unroll
                    for (int i = 0; i < 4; ++i) {
                        const float a = O[b][4 * j + i] - ob[i];
                        O[b][4 * j + i] = a;
                        ss += a * a;
                    }
                }
            ss = sum_halves(ss);
            const float rn = __builtin_amdgcn_rsqf(ss * (1.0f / DV) + EPS);
#pragma unroll
            for (int b = 0; b < NB; ++b)
#pragma unroll
                for (int j = 0; j < 4; ++j) {
                    const int dv = 32 * b + 8 * j + 4 * g;
                    *(u32x2*)(Yp + (size_t)qpos * ldy + dv) = (u32x2){pk_bf16(O[b][4 * j + 0] * rn, O[b][4 * j + 1] * rn),
                                                                      pk_bf16(O[b][4 * j + 2] * rn, O[b][4 * j + 3] * rn)};
                }
        }
    } else {
        const float inv0 = 1.0f / lt;
#pragma unroll
        for (int b = 0; b < NB; ++b)
#pragma unroll
            for (int j = 0; j < 4; ++j) {
                const int dv = 32 * b + 8 * j + 4 * g;
                *(u32x2*)(Yp + (size_t)qpos * ldy + dv) = (u32x2){pk_bf16(O[b][4 * j + 0] * inv0, O[b][4 * j + 1] * inv0),
                                                                  pk_bf16(O[b][4 * j + 2] * inv0, O[b][4 * j + 3] * inv0)};
            }
    }
}

__device__ __forceinline__ void phase_attn(const Params& p, int l, float lam, float lam_init, char* smem, int* s_item) {
    const int tid = opaque_tid(), wave = __builtin_amdgcn_readfirstlane(tid >> 6);
    int* ctr = (int*)(p.ws + OFF_CTR) + l;
    const bf16_t* QKDA = (const bf16_t*)(p.ws + OFF_QKDA);
    const bf16_t* VTDA = (const bf16_t*)(p.ws + OFF_VTDA);
    const bf16_t* QSW = (const bf16_t*)(p.ws + OFF_QSW);
    const bf16_t* KSW = (const bf16_t*)(p.ws + OFF_KSW);
    const bf16_t* VTSW = (const bf16_t*)(p.ws + OFF_VTSW);
    bf16_t* Y = (bf16_t*)(p.ws + OFF_Y);
    const int xcd = blockIdx.x & 7, slot = blockIdx.x >> 3, nslots = gridDim.x >> 3;
    (void)ctr; (void)s_item;
    for (int r = 0; r < 2; ++r)
        for (int j = slot; j < 32; j += nslots) {
            const int qb = r ? 31 - j : j, bh = 2 * xcd + r, b = bh >> 2, h = bh & 3;
            const int q0 = qb * 128;
            const float slope2 = exp2f(-2.0f * (h + 1)) * LOG2E;
            __syncthreads();
            attn_item<2, 128, false>(QKDA + (size_t)b * SEQ * 1024 + h * 128, 1024, QKDA + (size_t)b * SEQ * 1024 + 512 + h * 128, 1024,
                                     VTDA + (size_t)(b * 4 + h) * 128 * SEQ, Y + (size_t)b * SEQ * 512 + h * 128, 512, q0 + 32 * (wave >> 1),
                                     wave & 1, 0, q0 + 128, slope2, 0.f, lam, smem);
        }
    for (int j = slot; j < 64; j += nslots) {
        const int b = xcd >> 1, kvh = xcd & 1;
        const int q0 = j * 64, qw = q0 + 32 * (wave >> 2), head = kvh * 4 + (wave & 3);
        const float slope2 = exp2f(-(float)(head + 1)) * LOG2E;
        const float sink2 = p.sinks[l * 8 + head] * LOG2E;
        __syncthreads();
        attn_item<1, 64, true>(QSW + (size_t)b * SEQ * 512 + head * 64, 512, KSW + (size_t)b * SEQ * 128 + kvh * 64, 128,
                               VTSW + (size_t)(b * 2 + kvh) * 64 * SEQ, Y + (size_t)NTOK * 512 + (size_t)b * SEQ * 512 + head * 64, 512, qw, 0, q0 - 128,
                               q0 + 64, slope2, sink2, 0.f, smem);
    }
}

__device__ __forceinline__ void phase_branch(const Params& p, int l, char* smem) {
    const bf16_t* Yda = (const bf16_t*)(p.ws + OFF_Y);
    const bf16_t* Ysw = Yda + (size_t)NTOK * 512;
    for (int t = virt_block(); t < 64 * 4; t += gridDim.x) {
        int mt, nt;
        tile_order(t, 64, 4, mt, nt);
        BranchSched S{mt, nt, Yda, Ysw, (const bf16_t*)(p.ws + OFF_WT_DA + l * SZ_WT_BR), (const bf16_t*)(p.ws + OFF_WT_SW + l * SZ_WT_BR)};
        pg8::Gemm g{Yda, nullptr, NTOK, DM, 512};
        EpiBranch E{p.ws};
        __syncthreads();
        pg8::gemm_phase<EpiBranch, BranchSched, true, true>((__attribute__((address_space(3))) unsigned char*)smem, g, S, E);
    }
}

__device__ __forceinline__ void phase_resid(const Params& p, const bf16_t* A, int lda, const bf16_t* WT, int K, const float* xold, float* ssq, char* smem) {
    (void)lda;
    TileSched S{64, 4, virt_block(), (int)gridDim.x};
    pg8::Gemm g{A, WT, NTOK, DM, K};
    EpiResid E{p.ws, xold, ssq};
    __syncthreads();
    pg8::gemm_phase<EpiResid, TileSched, false, true>((__attribute__((address_space(3))) unsigned char*)smem, g, S, E);
}

__device__ __forceinline__ void phase_up(const Params& p, int l, char* smem) {
    const int tid = opaque_tid();
    const float* ssq = (const float*)(p.ws + OFF_SSQ_FFN);
    pg8::Gemm g{(const bf16_t*)(p.ws + OFF_XB), (const bf16_t*)(p.ws + OFF_WT_UP + l * SZ_WT_UP), NTOK, DFF2, DM};
    int tpar = 0;
    for (int t = virt_block(); t < 68 * 22; t += gridDim.x) {
        int mt, nt;
        tile_order(t, 68, 22, mt, nt);
        const int b = mt / 17, ti = mt % 17;
        const int pos0 = -2 + 254 * ti;
        float* rstd_s = (float*)(smem + RSTD_OFF) + (tpar & 1) * 256;
        ++tpar;
        if (tid < 256) {
            int pos = pos0 + tid;
            const bool zero = pos < 0;
            pos = pos < 0 ? 0 : (pos > SEQ - 1 ? SEQ - 1 : pos);
            const float rs = __builtin_amdgcn_rsqf(row_ssq(ssq, b * SEQ + pos) * (1.0f / DM) + EPS);
            rstd_s[tid] = zero ? 0.f : rs;
        }
        __syncthreads();
        OneUnit S{{0, nt, 0}, (long)b * SEQ + pos0};
        EpiUp E{p.ws, p.conv_w + (size_t)l * 3 * DFF2, p.conv_b + (size_t)l * DFF2, (lds_cfptr)rstd_s, b, pos0, nt};
        pg8::gemm_phase<EpiUp, OneUnit, false, true>((__attribute__((address_space(3))) unsigned char*)smem, g, S, E);
    }
}

__device__ __forceinline__ void phase_final(const Params& p) {
    const int tid = opaque_tid(), lane = tid & 63, wave = tid >> 6;
    const float* ssq = (const float*)(p.ws + OFF_SSQ_MIX);
    const bf16_t* XB = (const bf16_t*)(p.ws + OFF_XB);
    f32x4 w[4];
#pragma unroll
    for (int i = 0; i < 4; ++i) w[i] = *(const f32x4*)(p.norm_final_w + i * 256 + lane * 4);
    const int wstride = gridDim.x * 8;
    for (int row0 = blockIdx.x * 8 + wave; row0 < NTOK; row0 += 4 * wstride) {
        u32x2 xv[4][4];
        float sq[4];
#pragma unroll
        for (int rr = 0; rr < 4; ++rr) {
            const int row = row0 + rr * wstride;
            if (row < NTOK) {
#pragma unroll
                for (int i = 0; i < 4; ++i) xv[rr][i] = *(const u32x2*)(XB + (size_t)row * DM + i * 256 + lane * 4);
                sq[rr] = row_ssq(ssq, row);
            }
        }
#pragma unroll
        for (int rr = 0; rr < 4; ++rr) {
            const int row = row0 + rr * wstride;
            if (row < NTOK) {
                const float rs = __builtin_amdgcn_rsqf(sq[rr] * (1.0f / DM) + EPS);
                float* xr = p.out + (size_t)row * DM;
#pragma unroll
                for (int i = 0; i < 4; ++i) {
                    f32x4 v;
                    v[0] = bf2f_lo(xv[rr][i][0]) * rs * w[i][0]; v[1] = bf2f_hi(xv[rr][i][0]) * rs * w[i][1];
                    v[2] = bf2f_lo(xv[rr][i][1]) * rs * w[i][2]; v[3] = bf2f_hi(xv[rr][i][1]) * rs * w[i][3];
                    *(f32x4*)(xr + i * 256 + lane * 4) = v;
                }
            }
        }
    }
}

#define XB_TMO      128
#define XB_XCNT(j)  (256  + 64 * (j))
#define XB_XSUB(j)  (1280 + 64 * (j))
#define XB_XGEN(j)  (2304 + 64 * (j))
#define XB_TOP      3328
#define XB_TOPGEN   3392
#define XCD_BAR_WORDS 3456
#define XB_SPIN_CAP (1u << 22)
DEVI unsigned xb_ld(unsigned* p) { return __hip_atomic_load(p, __ATOMIC_RELAXED, __HIP_MEMORY_SCOPE_AGENT); }
DEVI unsigned xb_add(unsigned* p, unsigned v) { return __hip_atomic_fetch_add(p, v, __ATOMIC_RELAXED, __HIP_MEMORY_SCOPE_AGENT); }
DEVI unsigned xb_xcc_id() { return (unsigned)__builtin_amdgcn_s_getreg((3 << 11) | 20) & 0xFu; }
#define XB_SPIN(cond, bar) do { unsigned _sp = 0; while (cond) { __builtin_amdgcn_s_sleep(1); \
    if ((++_sp & 255u) == 0u) { if (xb_ld(&(bar)[XB_TMO])) break; if (_sp > XB_SPIN_CAP) { atomicAdd(&(bar)[XB_TMO], 1u); break; } } } } while (0)
DEVI void xcd_barrier_complete(unsigned* bar, unsigned x, unsigned& nloc, unsigned& nx) {
    const unsigned G = gridDim.x;
    unsigned sum, cnt, mine, sp = 0u;
    for (;;) {
        sum = 0u; cnt = 0u; mine = 0u;
#pragma unroll
        for (unsigned j = 0; j < 16; ++j) { const unsigned c = xb_ld(&bar[XB_XCNT(j)]); sum += c; cnt += (c > 0u) ? 1u : 0u; mine = (j == x) ? c : mine; }
        if (sum == G) break;
        __builtin_amdgcn_s_sleep(1);
        if ((++sp & 255u) == 0u) { if (xb_ld(&bar[XB_TMO])) break; if (sp > XB_SPIN_CAP) { atomicAdd(&bar[XB_TMO], 1u); break; } }
    }
    nloc = mine > 0u ? mine : 1u; nx = cnt > 0u ? cnt : 1u;
}
__device__ __attribute__((noinline)) void xcd_barrier(char* ws, volatile unsigned* st) {
    asm volatile("s_waitcnt vmcnt(0)" ::: "memory");
    __syncthreads();
    if (threadIdx.x == 0) {
        unsigned* bar = (unsigned*)(ws + OFF_BAR);
        const unsigned x = xb_xcc_id();
        __builtin_amdgcn_s_waitcnt(0);
        unsigned nloc = st[0], nx = st[1];
        if (nloc == 0u) { xcd_barrier_complete(bar, x, nloc, nx); st[0] = nloc; st[1] = nx; }
        const unsigned old = xb_add(&bar[XB_XSUB(x)], 1u);
        const unsigned gen = old / nloc;
        if (old + 1u == (gen + 1u) * nloc) {
            __builtin_amdgcn_fence(__ATOMIC_RELEASE, "agent");
            asm volatile("s_waitcnt vmcnt(0)" ::: "memory");
            const unsigned og = xb_add(&bar[XB_TOP], 1u);
            const unsigned tg = og / nx;
            if (og + 1u == (tg + 1u) * nx) xb_add(&bar[XB_TOPGEN], 1u);
            else XB_SPIN(xb_ld(&bar[XB_TOPGEN]) == tg, bar);
            __builtin_amdgcn_fence(__ATOMIC_ACQUIRE, "agent");
            xb_add(&bar[XB_XGEN(x)], 1u);
            asm volatile("s_waitcnt vmcnt(0)" ::: "memory");
        } else {
            XB_SPIN(xb_ld(&bar[XB_XGEN(x)]) == gen, bar);
            __builtin_amdgcn_fence(__ATOMIC_ACQUIRE, "agent");
            asm volatile("s_waitcnt vmcnt(0)" ::: "memory");
        }
    }
    __syncthreads();
}

__global__ void __launch_bounds__(NTHR) mega_kernel(Params p, int phase_lo, int phase_hi, int use_sync) {
    __shared__ __attribute__((aligned(16))) char smem[SMEM_BYTES];
    __shared__ int s_item;
    cg::grid_group grid = cg::this_grid();
    int ph = 0;
#define PHASE_BEGIN if (ph >= phase_lo && ph < phase_hi) {
    __shared__ __attribute__((aligned(16))) unsigned xb_words[4];
    if (threadIdx.x < 4) xb_words[threadIdx.x] = 0u;
    if (threadIdx.x == 0 && use_sync) (void)xb_add(&((unsigned*)(p.ws + OFF_BAR))[XB_XCNT(xb_xcc_id())], 1u);
    __syncthreads();
#define PHASE_END   if (use_sync) { if (phase_lo < 0) grid.sync(); else xcd_barrier(p.ws, xb_words); } } ++ph;
    PHASE_BEGIN phase_convert(p, smem); PHASE_END
    for (int l = 0; l < DEPTH; ++l) {
        const float lam_init = 0.8f - 0.6f * expf(-0.3f * (float)l);
        float d1 = 0.f, d2 = 0.f;
        for (int i = 0; i < 64; ++i) { d1 += p.lq1[l * 64 + i] * p.lk1[l * 64 + i]; d2 += p.lq2[l * 64 + i] * p.lk2[l * 64 + i]; }
        const float lam = expf(d1) - expf(d2) + lam_init;
        PHASE_BEGIN phase_inproj(p, l, smem); PHASE_END
        PHASE_BEGIN phase_attn(p, l, lam, lam_init, smem, &s_item); PHASE_END
        PHASE_BEGIN phase_branch(p, l, smem); PHASE_END
        PHASE_BEGIN phase_resid(p, (const bf16_t*)(p.ws + OFF_QKDA), 1024, (const bf16_t*)(p.ws + OFF_WT_MIX + l * SZ_WT_MIX), 1024,
                                l == 0 ? p.x : nullptr, (float*)(p.ws + OFF_SSQ_FFN), smem); PHASE_END
        PHASE_BEGIN phase_up(p, l, smem); PHASE_END
        PHASE_BEGIN phase_resid(p, (const bf16_t*)(p.ws + OFF_GATES), DFF, (const bf16_t*)(p.ws + OFF_WT_DN + l * SZ_WT_DN), DFF, nullptr,
                                (float*)(p.ws + OFF_SSQ_MIX), smem); PHASE_END
    }
    if (ph >= phase_lo && ph < phase_hi) phase_final(p);
}

extern "C" void kernel_launch(void* const* d_in, const int* in_sizes, int n_in, void* d_out, int out_size, void* d_ws, size_t ws_size,
                              hipStream_t stream) {
    static int grid_blocks = 0;
    if (!grid_blocks) {
        int dev = 0, cus = 0, per_cu = 0;
        hipGetDevice(&dev);
        hipDeviceGetAttribute(&cus, hipDeviceAttributeMultiprocessorCount, dev);
        hipOccupancyMaxActiveBlocksPerMultiprocessor(&per_cu, mega_kernel, NTHR, 0);
        if (per_cu > 1) per_cu = 1;
        if (per_cu < 1) per_cu = 1;
        grid_blocks = cus * per_cu;
    }
    Params p{};
    const float* const* in = (const float* const*)d_in;
    p.x = in[0]; p.norm_mix_w = in[1]; p.w_in = in[2]; p.lq1 = in[3]; p.lk1 = in[4]; p.lq2 = in[5]; p.lk2 = in[6];
    p.subln_w = in[7]; p.sinks = in[8]; p.w_br_da = in[9]; p.w_br_sw = in[10]; p.w_mix_out = in[11]; p.norm_ffn_w = in[12];
    p.w_up = in[13]; p.conv_w = in[14]; p.conv_b = in[15]; p.w_down = in[16]; p.norm_final_w = in[17];
    p.out = (float*)d_out;
    p.ws = (char*)d_ws;
    if (ws_size < WS_TOTAL) { fprintf(stderr, "workspace too small: %zu < %zu\n", ws_size, (size_t)WS_TOTAL); return; }
#ifndef MULTI_LAUNCH
#define MULTI_LAUNCH 0
#endif
#if MULTI_LAUNCH
    for (int ph = 0; ph < 2 + 6 * DEPTH; ++ph) mega_kernel<<<dim3(grid_blocks), dim3(NTHR), 0, stream>>>(p, ph, ph + 1, 0);
#else
    int lo = 0, hi = 1000, us = 1;
    void* args[] = {&p, &lo, &hi, &us};
    hipMemsetAsync((char*)d_ws + OFF_BAR, 0, XCD_BAR_WORDS * 4, stream);
    hipError_t e = hipLaunchCooperativeKernel((void*)mega_kernel, dim3(grid_blocks), dim3(NTHR), args, 0, stream);
    if (e != hipSuccess) fprintf(stderr, "cooperative launch failed: %s (grid %d)\n", hipGetErrorString(e), grid_blocks);
#endif
}
```

```cpp
#include <hip/hip_runtime.h>
#include <hip/hip_cooperative_groups.h>
#include <cstdio>
namespace cg = cooperative_groups;

typedef unsigned short bf16_t;
typedef short bf16x8 __attribute__((ext_vector_type(8)));
typedef float f32x16 __attribute__((ext_vector_type(16)));
typedef float f32x4 __attribute__((ext_vector_type(4)));
typedef unsigned u32x4 __attribute__((ext_vector_type(4)));
typedef unsigned u32x2 __attribute__((ext_vector_type(2)));

#define DEVI __device__ __forceinline__

constexpr int DM = 1024, NTOK = 16384, SEQ = 4096, DEPTH = 4;
constexpr int INC = 4352, DFF = 2816, DFF2 = 5632;
constexpr float EPS = 1e-6f;
constexpr float LOG2E = 1.4426950408889634f;
constexpr float QSCALE = 0.125f * LOG2E;

constexpr size_t SZ_WT_IN = (size_t)INC * DM * 2, SZ_WT_BR = (size_t)DM * 512 * 2, SZ_WT_MIX = (size_t)DM * DM * 2,
                 SZ_WT_UP = (size_t)DFF2 * DM * 2, SZ_WT_DN = (size_t)DM * DFF * 2;
constexpr size_t OFF_WT_IN = 0;
constexpr size_t OFF_WT_DA = OFF_WT_IN + DEPTH * SZ_WT_IN;
constexpr size_t OFF_WT_SW = OFF_WT_DA + DEPTH * SZ_WT_BR;
constexpr size_t OFF_WT_MIX = OFF_WT_SW + DEPTH * SZ_WT_BR;
constexpr size_t OFF_WT_UP = OFF_WT_MIX + DEPTH * SZ_WT_MIX;
constexpr size_t OFF_WT_DN = OFF_WT_UP + DEPTH * SZ_WT_UP;
constexpr size_t OFF_XB = OFF_WT_DN + DEPTH * SZ_WT_DN;
constexpr size_t OFF_SSQ_MIX = OFF_XB + (size_t)NTOK * DM * 2;
constexpr size_t OFF_SSQ_FFN = OFF_SSQ_MIX + (size_t)NTOK * 16 * 4;
constexpr size_t OFF_CTR = OFF_SSQ_FFN + (size_t)NTOK * 16 * 4;
constexpr size_t OFF_QKDA = OFF_CTR + 256;
constexpr size_t OFF_VTDA = OFF_QKDA + (size_t)NTOK * 1024 * 2;
constexpr size_t OFF_QSW = OFF_VTDA + (size_t)NTOK * 512 * 2;
constexpr size_t OFF_KSW = OFF_QSW + (size_t)NTOK * 512 * 2;
constexpr size_t OFF_VTSW = OFF_KSW + (size_t)NTOK * 128 * 2;
constexpr size_t OFF_GATES = OFF_VTSW + (size_t)NTOK * 128 * 2;
constexpr size_t OFF_Y = OFF_GATES + (size_t)NTOK * 2048 * 2;
constexpr size_t OFF_BAR = OFF_Y + (size_t)NTOK * 1024 * 2;
constexpr size_t WS_TOTAL = OFF_BAR + 16384;

struct Params {
    const float *x, *norm_mix_w, *w_in, *lq1, *lk1, *lq2, *lk2, *subln_w, *sinks, *w_br_da, *w_br_sw, *w_mix_out,
        *norm_ffn_w, *w_up, *conv_w, *conv_b, *w_down, *norm_final_w;
    float* out;
    char* ws;
};

constexpr int NTHR = 512;
constexpr int RSTD_OFF = 147456;
constexpr int SMEM_BYTES = 147456 + 2048;

typedef __bf16 bf16v2 __attribute__((ext_vector_type(2)));
typedef float f32x2 __attribute__((ext_vector_type(2)));
DEVI unsigned pk_bf16(float lo, float hi) {
    bf16v2 r = __builtin_convertvector((f32x2){lo, hi}, bf16v2);
    return __builtin_bit_cast(unsigned, r);
}
DEVI float bf2f_lo(unsigned u) { return __uint_as_float(u << 16); }
DEVI float bf2f_hi(unsigned u) { return __uint_as_float(u & 0xffff0000u); }
DEVI float fast_sigmoid(float x) { return __builtin_amdgcn_rcpf(1.0f + __builtin_amdgcn_exp2f(-x * LOG2E)); }
DEVI float sum_halves(float v) {
    u32x2 r = __builtin_amdgcn_permlane32_swap(__float_as_uint(v), __float_as_uint(v), false, false);
    return __uint_as_float(r[0]) + __uint_as_float(r[1]);
}
DEVI float max_halves(float v) {
    u32x2 r = __builtin_amdgcn_permlane32_swap(__float_as_uint(v), __float_as_uint(v), false, false);
    return fmaxf(__uint_as_float(r[0]), __uint_as_float(r[1]));
}
DEVI float row_ssq(const float* __restrict__ ssq, int tok) {
    const f32x4 a = *(const f32x4*)(ssq + (size_t)tok * 16), b = *(const f32x4*)(ssq + (size_t)tok * 16 + 4),
                c = *(const f32x4*)(ssq + (size_t)tok * 16 + 8), d = *(const f32x4*)(ssq + (size_t)tok * 16 + 12);
    return ((a[0] + a[1]) + (a[2] + a[3])) + ((b[0] + b[1]) + (b[2] + b[3])) + ((c[0] + c[1]) + (c[2] + c[3])) + ((d[0] + d[1]) + (d[2] + d[3]));
}
DEVI int opaque_tid() { int t = threadIdx.x; asm volatile("" : "+v"(t)); return t; }

__device__ __forceinline__ void convert_weights(const Params& p, char* smem, int l_lo, int l_hi, int vb, int nvb) {
    const int tid = opaque_tid();
    const int half = tid >> 8, ht = tid & 255;
    float* T = (float*)smem + half * (64 * 65);
    const int total = (l_hi - l_lo) * 3712;
    const int iters = (total + 2 * nvb - 1) / (2 * nvb);
    for (int it = 0; it < iters; ++it) {
        const int t = (it * nvb + vb) * 2 + half;
        const bool act = t < total;
        const int l = l_lo + (act ? t / 3712 : 0);
        int r = act ? t % 3712 : 0;
        const float* W;
        const float* sc = nullptr;
        bf16_t* D;
        int K, N, mode = 0, scmask = 0x7fffffff;
        float scmul = 1.0f;
        if (r < 1088) {
            W = p.w_in + (size_t)l * DM * INC; K = DM; N = INC; sc = p.norm_mix_w + l * DM;
            D = (bf16_t*)(p.ws + OFF_WT_IN + l * SZ_WT_IN);
        } else if ((r -= 1088) < 128) {
            W = p.w_br_da + (size_t)l * 512 * DM; K = 512; N = DM; D = (bf16_t*)(p.ws + OFF_WT_DA + l * SZ_WT_BR);
            sc = p.subln_w + l * 128; scmask = 127; scmul = 1.0f - (0.8f - 0.6f * expf(-0.3f * (float)l));
        } else if ((r -= 128) < 128) {
            W = p.w_br_sw + (size_t)l * 512 * DM; K = 512; N = DM; D = (bf16_t*)(p.ws + OFF_WT_SW + l * SZ_WT_BR);
        } else if ((r -= 128) < 256) {
            W = p.w_mix_out + (size_t)l * DM * DM; K = DM; N = DM; D = (bf16_t*)(p.ws + OFF_WT_MIX + l * SZ_WT_MIX);
        } else if ((r -= 256) < 1408) {
            W = p.w_up + (size_t)l * DM * DFF2; K = DM; N = DFF2; sc = p.norm_ffn_w + l * DM; mode = 1;
            D = (bf16_t*)(p.ws + OFF_WT_UP + l * SZ_WT_UP);
        } else {
            r -= 1408;
            W = p.w_down + (size_t)l * DFF * DM; K = DFF; N = DM; D = (bf16_t*)(p.ws + OFF_WT_DN + l * SZ_WT_DN);
        }
        const int ntn = N >> 6;
        const int k0 = (r / ntn) * 64, n0 = (r % ntn) * 64;
        __syncthreads();
        if (act) {
#pragma unroll
            for (int i = 0; i < 4; ++i) {
                const int kr = (ht >> 4) + 16 * i, c4 = (ht & 15) * 4;
                f32x4 v = *(const f32x4*)(W + (size_t)(k0 + kr) * N + n0 + c4);
                const float s_ = sc ? sc[(k0 + kr) & scmask] * scmul : 1.0f;
                T[kr * 65 + c4 + 0] = v[0] * s_; T[kr * 65 + c4 + 1] = v[1] * s_;
                T[kr * 65 + c4 + 2] = v[2] * s_; T[kr * 65 + c4 + 3] = v[3] * s_;
            }
        }
        __syncthreads();
        if (act) {
            const int nl = ht >> 2, kc = (ht & 3) * 16;
            int n = n0 + nl;
            if (mode == 1) n = (n < DFF) ? ((n >> 7) * 256 + (n & 127)) : (((n - DFF) >> 7) * 256 + 128 + ((n - DFF) & 127));
            unsigned o[8];
#pragma unroll
            for (int e = 0; e < 8; ++e) o[e] = pk_bf16(T[(kc + 2 * e) * 65 + nl], T[(kc + 2 * e + 1) * 65 + nl]);
            bf16_t* dst = D + (size_t)n * K + k0 + kc;
            *(u32x4*)dst = (u32x4){o[0], o[1], o[2], o[3]};
            *(u32x4*)(dst + 8) = (u32x4){o[4], o[5], o[6], o[7]};
        }
    }
}

__device__ __forceinline__ void phase_convert(const Params& p, char* smem) {
    convert_weights(p, smem, 0, 1, blockIdx.x, gridDim.x);
    const int tid = opaque_tid();
    {
        const int lane = tid & 63, wave = tid >> 6;
        bf16_t* XB = (bf16_t*)(p.ws + OFF_XB);
        float* ssq = (float*)(p.ws + OFF_SSQ_MIX);
        const int wstride = gridDim.x * 8;
        for (int row0 = blockIdx.x * 8 + wave; row0 < NTOK; row0 += 4 * wstride) {
            f32x4 v[4][4];
#pragma unroll
            for (int rr = 0; rr < 4; ++rr) {
                const int row = row0 + rr * wstride;
                if (row < NTOK) {
#pragma unroll
                    for (int i = 0; i < 4; ++i) v[rr][i] = *(const f32x4*)(p.x + (size_t)row * DM + i * 256 + lane * 4);
                }
            }
#pragma unroll
            for (int rr = 0; rr < 4; ++rr) {
                const int row = row0 + rr * wstride;
                if (row < NTOK) {
                    float s = 0.f;
#pragma unroll
                    for (int i = 0; i < 4; ++i) {
                        s += v[rr][i][0] * v[rr][i][0] + v[rr][i][1] * v[rr][i][1] + v[rr][i][2] * v[rr][i][2] + v[rr][i][3] * v[rr][i][3];
                        *(u32x2*)(XB + (size_t)row * DM + i * 256 + lane * 4) = (u32x2){pk_bf16(v[rr][i][0], v[rr][i][1]), pk_bf16(v[rr][i][2], v[rr][i][3])};
                    }
#pragma unroll
                    for (int o = 32; o >= 1; o >>= 1) s += __shfl_xor(s, o, 64);
                    if (lane < 16) ssq[(size_t)row * 16 + lane] = (lane == 0) ? s : 0.f;
                }
            }
        }
    }
}

DEVI int virt_block() { return (blockIdx.x & 7) * (gridDim.x >> 3) + (blockIdx.x >> 3); }
DEVI void tile_order(int t, int MT, int NT, int& mt, int& nt) {
    const int grp = t / (8 * NT);
    const int first = grp * 8;
    const int gsz = (MT - first) < 8 ? (MT - first) : 8;
    const int rem = t - grp * 8 * NT;
    mt = first + rem % gsz;
    nt = rem / gsz;
}

namespace pg8 {
#define PG8_LAS __attribute__((address_space(3)))
constexpr int BM = 256, BK = 64, HALF = 128, HTB = HALF * BK * 2  , STAGE_BYTES = 8 * HTB, NXCD = 8, WGM = 8;

__host__ __device__ __forceinline__ int lds_byte(int r, int c) { const int st = (r >> 4) * 2 + (c >> 5), rr = r & 15, cc = c & 31, ob = rr * 64 + cc * 2; return st * 1024 + (ob ^ (((ob >> 9) & 1) << 5)); }
__host__ __device__ __forceinline__ void stage_rc(int b, int& R, int& C) { const int st = b / 1024, sb = b % 1024, swz = sb ^ (((sb >> 9) & 1) << 5); R = (st >> 1) * 16 + swz / 64; C = (st & 1) * 32 + (swz % 64) / 2; }
__host__ __device__ __forceinline__ int perm32(int rho) { const int n = rho >> 4, i = rho & 15; return 8 * (i >> 2) + 4 * n + (i & 3); }
struct Unit { int pm, pn, idx; };
struct Gemm { const bf16_t* A; const bf16_t* Bt; int M, N, K; };
template <class Epi, class Sched, bool ALIGN_EPI = false, bool SP2 = false>
__device__ __forceinline__ void gemm_phase(PG8_LAS unsigned char* lds, const Gemm g, const Sched& S, const Epi& E) {
    const int tid = opaque_tid(), wid = __builtin_amdgcn_readfirstlane(tid >> 6), lane = tid & 63, wr = wid >> 2, wc = wid & 3, fr = lane & 15, fq = lane >> 4;
    const int K = g.K, nt = K / BK;
    unsigned voffA[2], voffB[2];
#pragma unroll
    for (int i = 0; i < 2; ++i) { int R, C; stage_rc(tid * 16 + i * 8192, R, C); const int Rb = Epi::PERM ? ((R & ~31) + perm32(R & 31)) : R;
        voffA[i] = (unsigned)(R * K + C) * 2u; voffB[i] = (unsigned)(Rb * K + C) * 2u; }
    const size_t kstep = (size_t)(BK * 2);
    const size_t hstep = (size_t)HALF * K * 2;
    const size_t tstep = 2 * hstep;
    const unsigned ldsw = (unsigned)wid * 1024u;
    const int aoff = lds_byte(wr * 64 + fr, fq * 8), boff = lds_byte(wc * 32 + fr, fq * 8);
#define PG8_SA(b, h) (((b) * 2 + (h)) * HTB)
#define PG8_SB(b, h) ((4 + (b) * 2 + (h)) * HTB)
#define PG8_STAGE(bufoff, gbase, voff) do { _Pragma("unroll") for (int _i = 0; _i < 2; ++_i) \
        __builtin_amdgcn_global_load_lds((const unsigned*)((const char*)(gbase) + (voff)[_i]), (PG8_LAS unsigned*)(lds + (bufoff) + ldsw + _i * 8192), 16, 0, 0); } while (0)
#define PG8_LDA(dst, b, h) do { _Pragma("unroll") for (int m = 0; m < 4; ++m) _Pragma("unroll") for (int k = 0; k < 2; ++k) dst[m][k] = *(const PG8_LAS bf16x8*)(lds + PG8_SA(b, h) + aoff + m * 2048 + k * 1024); } while (0)
#define PG8_LDB(dst, b, h) do { _Pragma("unroll") for (int n = 0; n < 2; ++n) _Pragma("unroll") for (int k = 0; k < 2; ++k) dst[n][k] = *(const PG8_LAS bf16x8*)(lds + PG8_SB(b, h) + boff + n * 2048 + k * 1024); } while (0)
#define PG8_MMA(ai, bj, At, Bt) do { __builtin_amdgcn_s_setprio(1); _Pragma("unroll") for (int m = 0; m < 4; ++m) _Pragma("unroll") for (int n = 0; n < 2; ++n) _Pragma("unroll") for (int k = 0; k < 2; ++k) \
        acc[ai][bj][m][n] = __builtin_amdgcn_mfma_f32_16x16x32_bf16(Bt[n][k], At[m][k], acc[ai][bj][m][n], 0, 0, 0); __builtin_amdgcn_s_setprio(0); } while (0)
#define PG8_WAIT_V(n) asm volatile("s_waitcnt vmcnt(" #n ")" ::: "memory")
#define PG8_WAIT_L(n) asm volatile("s_waitcnt lgkmcnt(" #n ")" ::: "memory")
#define PG8_BAR __builtin_amdgcn_s_barrier()
#define PG8_SCHED __builtin_amdgcn_sched_barrier(0)
    Unit cur, nxt; int ui = 0;
    if (!S.next(0, cur)) return;
    f32x4 acc[2][2][4][2];
#pragma unroll
    for (int a = 0; a < 2; ++a)
#pragma unroll
        for (int b = 0; b < 2; ++b)
#pragma unroll
            for (int m = 0; m < 4; ++m)
#pragma unroll
                for (int n = 0; n < 2; ++n) acc[a][b][m][n] = (f32x4){0.f, 0.f, 0.f, 0.f};
    bf16x8 At[4][2], B0[2][2], B1[2][2];
    const char* cA = S.a_ptr(g, cur); const char* cB = S.b_ptr(g, cur);
    S.a_ready(cur);
    if constexpr (SP2) {
        PG8_STAGE(PG8_SB(0, 0), cB, voffB); PG8_STAGE(PG8_SB(0, 1), cB + hstep, voffB); PG8_STAGE(PG8_SA(0, 0), cA, voffA); PG8_STAGE(PG8_SA(0, 1), cA + hstep, voffA);
        if (wr == 1) PG8_BAR;
        PG8_WAIT_V(2); PG8_BAR;
        PG8_STAGE(PG8_SB(1, 0), cB + kstep, voffB); PG8_STAGE(PG8_SA(1, 0), cA + kstep, voffA); PG8_STAGE(PG8_SB(1, 1), cB + hstep + kstep, voffB);
        PG8_WAIT_V(6); PG8_BAR;
    } else {
        PG8_STAGE(PG8_SB(0, 0), cB, voffB); PG8_STAGE(PG8_SA(0, 0), cA, voffA); PG8_STAGE(PG8_SB(0, 1), cB + hstep, voffB); PG8_STAGE(PG8_SA(0, 1), cA + hstep, voffA);
        if (wr == 1) PG8_BAR;
        PG8_WAIT_V(4); PG8_BAR;
        PG8_STAGE(PG8_SB(1, 0), cB + kstep, voffB); PG8_STAGE(PG8_SA(1, 0), cA + kstep, voffA); PG8_STAGE(PG8_SB(1, 1), cB + hstep + kstep, voffB);
        PG8_WAIT_V(6); PG8_BAR;
    }
    for (;;) {
        const bool has_next = S.next(ui + 1, nxt);
        const char* nA = has_next ? S.a_ptr(g, nxt) : cA; const char* nB = has_next ? S.b_ptr(g, nxt) : cB;
        for (int t = 0; t < nt; t += 2) {
            const bool last = (t == nt - 2);
            const char* a1 = cA + (size_t)(t + 1) * kstep;
            const char* a2 = last ? nA : cA + (size_t)(t + 2) * kstep; const char* b2 = last ? nB : cB + (size_t)(t + 2) * kstep;
            const char* a3 = a2 + kstep; const char* b3 = b2 + kstep;
            if (last && has_next) S.a_ready(nxt);
            if constexpr (SP2) {
            PG8_LDB(B0, 0, 0); PG8_LDB(B1, 0, 1); PG8_SCHED; PG8_LDA(At, 0, 0); PG8_STAGE(PG8_SA(1, 1), a1 + hstep, voffA);
            PG8_WAIT_V(8); PG8_WAIT_L(0); PG8_BAR; PG8_MMA(0, 0, At, B0); PG8_MMA(0, 1, At, B1); PG8_BAR; PG8_SCHED;
            PG8_LDA(At, 0, 1); PG8_STAGE(PG8_SB(0, 0), b2, voffB); PG8_STAGE(PG8_SB(0, 1), b2 + hstep, voffB); PG8_STAGE(PG8_SA(0, 0), a2, voffA);
            PG8_WAIT_V(8); PG8_WAIT_L(0); PG8_BAR; PG8_MMA(1, 0, At, B0); PG8_MMA(1, 1, At, B1); PG8_BAR; PG8_SCHED;
            PG8_LDB(B0, 1, 0); PG8_LDB(B1, 1, 1); PG8_SCHED; PG8_LDA(At, 1, 0); PG8_STAGE(PG8_SA(0, 1), a2 + hstep, voffA);
            PG8_WAIT_V(8); PG8_WAIT_L(0); PG8_BAR; PG8_MMA(0, 0, At, B0); PG8_MMA(0, 1, At, B1); PG8_BAR; PG8_SCHED;
            PG8_LDA(At, 1, 1); PG8_STAGE(PG8_SB(1, 0), b3, voffB); PG8_STAGE(PG8_SB(1, 1), b3 + hstep, voffB); PG8_STAGE(PG8_SA(1, 0), a3, voffA);
            PG8_WAIT_V(8); PG8_WAIT_L(0); PG8_BAR; PG8_MMA(1, 0, At, B0); PG8_MMA(1, 1, At, B1); PG8_BAR; PG8_SCHED;
            } else {
            PG8_LDB(B0, 0, 0); PG8_SCHED; PG8_LDA(At, 0, 0); PG8_STAGE(PG8_SA(1, 1), a1 + hstep, voffA);
            PG8_WAIT_L(8); PG8_BAR; PG8_WAIT_L(0); PG8_MMA(0, 0, At, B0); PG8_BAR; PG8_SCHED;
            PG8_LDB(B1, 0, 1); PG8_STAGE(PG8_SB(0, 0), b2, voffB);
            PG8_BAR; PG8_WAIT_L(0); PG8_MMA(0, 1, At, B1); PG8_BAR;
            PG8_LDA(At, 0, 1); PG8_STAGE(PG8_SA(0, 0), a2, voffA);
            PG8_BAR; PG8_WAIT_L(0); PG8_MMA(1, 0, At, B0); PG8_BAR; PG8_SCHED;
            PG8_STAGE(PG8_SB(0, 1), b2 + hstep, voffB);
            PG8_WAIT_V(6); PG8_BAR; PG8_MMA(1, 1, At, B1); PG8_BAR;
            PG8_LDB(B0, 1, 0); PG8_SCHED; PG8_LDA(At, 1, 0); PG8_STAGE(PG8_SA(0, 1), a2 + hstep, voffA);
            PG8_WAIT_L(8); PG8_BAR; PG8_WAIT_L(0); PG8_MMA(0, 0, At, B0); PG8_BAR; PG8_SCHED;
            PG8_LDB(B1, 1, 1); PG8_STAGE(PG8_SB(1, 0), b3, voffB);
            PG8_BAR; PG8_WAIT_L(0); PG8_MMA(0, 1, At, B1); PG8_BAR;
            PG8_LDA(At, 1, 1); PG8_STAGE(PG8_SA(1, 0), a3, voffA);
            PG8_BAR; PG8_WAIT_L(0); PG8_MMA(1, 0, At, B0); PG8_BAR; PG8_SCHED;
            PG8_STAGE(PG8_SB(1, 1), b3 + hstep, voffB);
            PG8_WAIT_V(6); PG8_BAR; PG8_MMA(1, 1, At, B1); PG8_BAR;
            }
        }
        if constexpr (ALIGN_EPI) { if (wr == 0) PG8_BAR; }
        if constexpr (!Epi::AFTER_DRAIN) { E(acc, cur, wr, wc, fr, fq); S.done(cur); }
        if (!has_next) break;
        if (!S.keep(nxt)) {
#pragma unroll
        for (int a = 0; a < 2; ++a)
#pragma unroll
            for (int b = 0; b < 2; ++b)
#pragma unroll
                for (int m = 0; m < 4; ++m)
#pragma unroll
                    for (int n = 0; n < 2; ++n) acc[a][b][m][n] = (f32x4){0.f, 0.f, 0.f, 0.f};
        }
        cur = nxt; cA = nA; cB = nB; ++ui;
        if constexpr (ALIGN_EPI) { if (wr == 1) PG8_BAR; }
    }
    PG8_WAIT_V(0);
    if constexpr (!ALIGN_EPI) { if (wr == 0) PG8_BAR; }
    PG8_BAR;
    if constexpr (Epi::AFTER_DRAIN) { E.fused(acc, cur, wr, wc, fr, fq, lds, wid, lane); S.done(cur); }
#undef PG8_SA
#undef PG8_SB
#undef PG8_STAGE
#undef PG8_LDA
#undef PG8_LDB
#undef PG8_MMA
#undef PG8_WAIT_V
#undef PG8_WAIT_L
#undef PG8_BAR
#undef PG8_SCHED
}
}

struct TileSched {
    int MT, NT, vb, G;
    DEVI bool next(int i, pg8::Unit& u) const {
        const int t = i * G + vb;
        if (t >= MT * NT) return false;
        tile_order(t, MT, NT, u.pm, u.pn);
        u.idx = i;
        return true;
    }
    DEVI const char* a_ptr(const pg8::Gemm& g, const pg8::Unit& u) const { return (const char*)g.A + (size_t)u.pm * 256 * g.K * 2; }
    DEVI const char* b_ptr(const pg8::Gemm& g, const pg8::Unit& u) const { return (const char*)g.Bt + (size_t)u.pn * 256 * g.K * 2; }
    DEVI bool keep(const pg8::Unit&) const { return false; }
    DEVI void a_ready(const pg8::Unit&) const {}
    DEVI void done(const pg8::Unit&) const {}
};
struct BranchSched {
    int pm, pn; const bf16_t *A1, *A2, *B1, *B2;
    DEVI bool next(int i, pg8::Unit& u) const { if (i > 1) return false; u.pm = pm; u.pn = pn; u.idx = i; return true; }
    DEVI const char* a_ptr(const pg8::Gemm& g, const pg8::Unit& u) const { return (const char*)(u.idx ? A2 : A1) + (size_t)u.pm * 256 * g.K * 2; }
    DEVI const char* b_ptr(const pg8::Gemm& g, const pg8::Unit& u) const { return (const char*)(u.idx ? B2 : B1) + (size_t)u.pn * 256 * g.K * 2; }
    DEVI bool keep(const pg8::Unit& u) const { return u.idx == 1; }
    DEVI void a_ready(const pg8::Unit&) const {}
    DEVI void done(const pg8::Unit&) const {}
};
struct OneUnit {
    pg8::Unit u; long a_row0;
    DEVI bool next(int i, pg8::Unit& o) const { if (i) return false; o = u; return true; }
    DEVI const char* a_ptr(const pg8::Gemm& g, const pg8::Unit&) const { return (const char*)g.A + a_row0 * (long)g.K * 2; }
    DEVI const char* b_ptr(const pg8::Gemm& g, const pg8::Unit& o) const { return (const char*)g.Bt + (size_t)o.pn * 256 * g.K * 2; }
    DEVI bool keep(const pg8::Unit&) const { return false; }
    DEVI void a_ready(const pg8::Unit&) const {}
    DEVI void done(const pg8::Unit&) const {}
};
typedef const __attribute__((address_space(3))) float* lds_cfptr;

struct EpiInproj {
    static constexpr bool PERM = true, AFTER_DRAIN = false;
    char* ws; lds_cfptr rstd_all;
    DEVI void operator()(const f32x4 (&acc)[2][2][4][2], const pg8::Unit& u, int wr, int wc, int fr, int fq) const {
        lds_cfptr rs_u = rstd_all + u.idx * 256;
        const int m0 = u.pm * 256;
#pragma unroll
        for (int bj = 0; bj < 2; ++bj) {
            const int cb = u.pn * 256 + bj * 128 + wc * 32;
            const bool isv = (cb >= 1024 && cb < 1536) || (cb >= 2176 && cb < 2304);
            if (!isv) {
                bf16_t* dst; int ld, coff, mode;
                if (cb < 512) { dst = (bf16_t*)(ws + OFF_QKDA); ld = 1024; coff = cb; mode = 0; }
                else if (cb < 1024) { dst = (bf16_t*)(ws + OFF_QKDA); ld = 1024; coff = cb; mode = 1; }
                else if (cb < 2048) { dst = (bf16_t*)(ws + OFF_QSW); ld = 512; coff = cb - 1536; mode = 0; }
                else if (cb < 2176) { dst = (bf16_t*)(ws + OFF_KSW); ld = 128; coff = cb - 2048; mode = 1; }
                else { dst = (bf16_t*)(ws + OFF_GATES); ld = 2048; coff = cb - 2304; mode = 2; }
#pragma unroll
                for (int ai = 0; ai < 2; ++ai)
#pragma unroll
                    for (int m = 0; m < 4; ++m) {
                        const int rl = ai * 128 + wr * 64 + m * 16 + fr;
                        float rs = rs_u[rl];
                        if (mode == 0) rs *= QSCALE;
                        f32x4 v0 = acc[ai][bj][m][0] * rs, v1 = acc[ai][bj][m][1] * rs;
                        if (mode == 2) {
#pragma unroll
                            for (int e = 0; e < 4; ++e) { v0[e] = fast_sigmoid(v0[e]); v1[e] = fast_sigmoid(v1[e]); }
                        }
                        *(u32x4*)(dst + (size_t)(m0 + rl) * ld + coff + fq * 8) =
                            (u32x4){pk_bf16(v0[0], v0[1]), pk_bf16(v0[2], v0[3]), pk_bf16(v1[0], v1[1]), pk_bf16(v1[2], v1[3])};
                    }
            } else {
                bf16_t* dst; int rowbase, rows_per_b;
                const int b = m0 >> 12, s0 = m0 & 4095;
                if (cb < 1536) { dst = (bf16_t*)(ws + OFF_VTDA); rowbase = cb - 1024; rows_per_b = 512; }
                else { dst = (bf16_t*)(ws + OFF_VTSW); rowbase = cb - 2176; rows_per_b = 128; }
#pragma unroll
                for (int ai = 0; ai < 2; ++ai)
#pragma unroll
                    for (int m = 0; m < 4; ++m) {
                        const int rl = ai * 128 + wr * 64 + m * 16 + fr;
                        const float rs = rs_u[rl];
                        bf16_t* d = dst + (size_t)(b * rows_per_b + rowbase + fq * 8) * SEQ + s0 + rl;
#pragma unroll
                        for (int n = 0; n < 2; ++n)
#pragma unroll
                            for (int e = 0; e < 4; e += 2) {
                                const unsigned pk = pk_bf16(acc[ai][bj][m][n][e] * rs, acc[ai][bj][m][n][e + 1] * rs);
                                d[(size_t)(4 * n + e) * SEQ] = (bf16_t)(pk & 0xffffu);
                                d[(size_t)(4 * n + e + 1) * SEQ] = (bf16_t)(pk >> 16);
                            }
                    }
            }
        }
    }
};

struct EpiBranch {
    static constexpr bool PERM = true, AFTER_DRAIN = false;
    char* ws;
    DEVI void operator()(f32x4 (&acc)[2][2][4][2], const pg8::Unit& u, int wr, int wc, int fr, int fq) const {
        asm volatile("" : "+v"(fr), "+v"(fq));
        const bf16_t* G = (const bf16_t*)(ws + OFF_GATES);
        bf16_t* MG = (bf16_t*)(ws + OFF_QKDA);
        const int m0 = u.pm * 256, c0 = u.pn * 256 + wc * 32 + fq * 8;
        if (u.idx == 0) {
#pragma unroll
            for (int am = 0; am < 8; ++am) {
                const int ai = am >> 2, m = am & 3;
                u32x4 g1[2], g2[2];
#pragma unroll
                for (int bj = 0; bj < 2; ++bj) {
                    const bf16_t* gp = G + (size_t)(m0 + ai * 128 + wr * 64 + m * 16 + fr) * 2048 + c0 + bj * 128;
                    g1[bj] = *(const u32x4*)gp;
                    g2[bj] = *(const u32x4*)(gp + 1024);
                }
#pragma unroll
                for (int bj = 0; bj < 2; ++bj)
#pragma unroll
                    for (int n = 0; n < 2; ++n) {
                        const unsigned a = g1[bj][2 * n], b = g1[bj][2 * n + 1], c = g2[bj][2 * n], d = g2[bj][2 * n + 1];
                        acc[ai][bj][m][n][0] *= bf2f_lo(a) * __builtin_amdgcn_rcpf(bf2f_lo(c));
                        acc[ai][bj][m][n][1] *= bf2f_hi(a) * __builtin_amdgcn_rcpf(bf2f_hi(c));
                        acc[ai][bj][m][n][2] *= bf2f_lo(b) * __builtin_amdgcn_rcpf(bf2f_lo(d));
                        acc[ai][bj][m][n][3] *= bf2f_hi(b) * __builtin_amdgcn_rcpf(bf2f_hi(d));
                    }
                __builtin_amdgcn_sched_barrier(0);
            }
        } else {
#pragma unroll
            for (int am = 0; am < 8; ++am) {
                const int ai = am >> 2, m = am & 3;
                u32x4 g2[2];
#pragma unroll
                for (int bj = 0; bj < 2; ++bj) g2[bj] = *(const u32x4*)(G + (size_t)(m0 + ai * 128 + wr * 64 + m * 16 + fr) * 2048 + 1024 + c0 + bj * 128);
#pragma unroll
                for (int bj = 0; bj < 2; ++bj) {
                    const u32x4 gg = g2[bj];
                    const f32x4 a0 = acc[ai][bj][m][0], a1 = acc[ai][bj][m][1];
                    *(u32x4*)(MG + (size_t)(m0 + ai * 128 + wr * 64 + m * 16 + fr) * 1024 + c0 + bj * 128) =
                        (u32x4){pk_bf16(a0[0] * bf2f_lo(gg[0]), a0[1] * bf2f_hi(gg[0])), pk_bf16(a0[2] * bf2f_lo(gg[1]), a0[3] * bf2f_hi(gg[1])),
                                pk_bf16(a1[0] * bf2f_lo(gg[2]), a1[1] * bf2f_hi(gg[2])), pk_bf16(a1[2] * bf2f_lo(gg[3]), a1[3] * bf2f_hi(gg[3]))};
                }
                if (am & 1) __builtin_amdgcn_sched_barrier(0);
            }
        }
    }
};

struct EpiResid {
    static constexpr bool PERM = true, AFTER_DRAIN = false;
    char* ws; const float* xold; float* ssq;
    DEVI void operator()(const f32x4 (&acc)[2][2][4][2], const pg8::Unit& u, int wr, int wc, int fr, int fq) const {
        bf16_t* XB = (bf16_t*)(ws + OFF_XB);
        const int m0 = u.pm * 256, c0 = u.pn * 256 + wc * 32 + fq * 8;
#pragma unroll
        for (int ai = 0; ai < 2; ++ai) {
            u32x4 xo[4][2];
            if (!xold) {
#pragma unroll
                for (int m = 0; m < 4; ++m)
#pragma unroll
                    for (int bj = 0; bj < 2; ++bj) xo[m][bj] = *(const u32x4*)(XB + (size_t)(m0 + ai * 128 + wr * 64 + m * 16 + fr) * DM + c0 + bj * 128);
            }
#pragma unroll
            for (int m = 0; m < 4; ++m) {
                const int tok = m0 + ai * 128 + wr * 64 + m * 16 + fr;
                float sq = 0.f;
#pragma unroll
                for (int bj = 0; bj < 2; ++bj) {
                    f32x4 a0, a1;
                    if (xold) { a0 = *(const f32x4*)(xold + (size_t)tok * DM + c0 + bj * 128); a1 = *(const f32x4*)(xold + (size_t)tok * DM + c0 + bj * 128 + 4); }
                    else {
                        const u32x4 w = xo[m][bj];
                        a0 = (f32x4){bf2f_lo(w[0]), bf2f_hi(w[0]), bf2f_lo(w[1]), bf2f_hi(w[1])};
                        a1 = (f32x4){bf2f_lo(w[2]), bf2f_hi(w[2]), bf2f_lo(w[3]), bf2f_hi(w[3])};
                    }
                    a0 += acc[ai][bj][m][0]; a1 += acc[ai][bj][m][1];
                    sq += a0[0] * a0[0] + a0[1] * a0[1] + a0[2] * a0[2] + a0[3] * a0[3] + a1[0] * a1[0] + a1[1] * a1[1] + a1[2] * a1[2] + a1[3] * a1[3];
                    *(u32x4*)(XB + (size_t)tok * DM + c0 + bj * 128) = (u32x4){pk_bf16(a0[0], a0[1]), pk_bf16(a0[2], a0[3]), pk_bf16(a1[0], a1[1]), pk_bf16(a1[2], a1[3])};
                }
                sq += __shfl_xor(sq, 16, 64);
                sq = sum_halves(sq);
                if (fq == 0) ssq[(size_t)tok * 16 + u.pn * 4 + wc] = sq;
            }
        }
    }
};

constexpr int USTRB = 520;
struct EpiUp {
    static constexpr bool PERM = true, AFTER_DRAIN = true;
    char* ws; const float* cw; const float* cb; lds_cfptr rstd_s; int b, pos0, nt;
    DEVI void operator()(const f32x4 (&)[2][2][4][2], const pg8::Unit&, int, int, int, int) const {}
    DEVI void fused(const f32x4 (&acc)[2][2][4][2], const pg8::Unit&, int wr, int wc, int fr, int fq, __attribute__((address_space(3))) unsigned char* lds,
                    int, int) const {
        bf16_t* H = (bf16_t*)(ws + OFF_GATES);
#pragma unroll
        for (int ai = 0; ai < 2; ++ai)
#pragma unroll
            for (int m = 0; m < 4; ++m) {
                const int rl = ai * 128 + wr * 64 + m * 16 + fr;
                const float rs = rstd_s[rl];
#pragma unroll
                for (int bj = 0; bj < 2; ++bj) {
                    const f32x4 v0 = acc[ai][bj][m][0] * rs, v1 = acc[ai][bj][m][1] * rs;
                    *(__attribute__((address_space(3))) u32x4*)(lds + rl * USTRB + (bj * 128 + wc * 32 + fq * 8) * 2) =
                        (u32x4){pk_bf16(v0[0], v0[1]), pk_bf16(v0[2], v0[3]), pk_bf16(v1[0], v1[1]), pk_bf16(v1[2], v1[3])};
                }
            }
        __syncthreads();
        const int tid = threadIdx.x;
        const int j4 = (tid & 31) * 4, r0 = (tid >> 5) * 16;
        const int jg = nt * 128 + j4;
        f32x4 wg[3], wv[3], bg, bv;
#pragma unroll
        for (int i = 0; i < 3; ++i) { wg[i] = *(const f32x4*)(cw + i * DFF2 + jg); wv[i] = *(const f32x4*)(cw + i * DFF2 + DFF + jg); }
        bg = *(const f32x4*)(cb + jg);
        bv = *(const f32x4*)(cb + DFF + jg);
        auto ldrow = [&](int r, f32x4& ug, f32x4& uv) {
            const u32x2 a = *(const __attribute__((address_space(3))) u32x2*)(lds + r * USTRB + j4 * 2);
            const u32x2 c = *(const __attribute__((address_space(3))) u32x2*)(lds + r * USTRB + 256 + j4 * 2);
            ug = (f32x4){bf2f_lo(a[0]), bf2f_hi(a[0]), bf2f_lo(a[1]), bf2f_hi(a[1])};
            uv = (f32x4){bf2f_lo(c[0]), bf2f_hi(c[0]), bf2f_lo(c[1]), bf2f_hi(c[1])};
        };
        f32x4 g2, v2, g1, v1;
        ldrow(r0 >= 2 ? r0 - 2 : 0, g2, v2);
        ldrow(r0 >= 1 ? r0 - 1 : 0, g1, v1);
#pragma unroll 4
        for (int i = 0; i < 16; ++i) {
            const int r = r0 + i;
            f32x4 g0, v0;
            ldrow(r, g0, v0);
            const int pos = pos0 + r;
            if (r >= 2 && pos < SEQ) {
                const f32x4 cg_ = bg + g2 * wg[0] + g1 * wg[1] + g0 * wg[2];
                const f32x4 cv_ = bv + v2 * wv[0] + v1 * wv[1] + v0 * wv[2];
                f32x4 sg;
#pragma unroll
                for (int e = 0; e < 4; ++e) sg[e] = fast_sigmoid(cg_[e]);
                const f32x4 hh = cg_ * sg * cv_;
                *(u32x2*)(H + (size_t)(b * SEQ + pos) * DFF + jg) = (u32x2){pk_bf16(hh[0], hh[1]), pk_bf16(hh[2], hh[3])};
            }
            g2 = g1; v2 = v1; g1 = g0; v1 = v0;
        }
    }
};

__device__ __forceinline__ void phase_inproj(const Params& p, int l, char* smem) {
    const int tid = opaque_tid();
    const float* ssq = (const float*)(p.ws + OFF_SSQ_MIX);
    TileSched S{64, 17, virt_block(), (int)gridDim.x};
    float* rstd_all = (float*)(smem + 131072);
    for (int i = 0; i < 8; ++i) {
        pg8::Unit u;
        if (!S.next(i, u)) break;
        if (tid < 256) rstd_all[i * 256 + tid] = __builtin_amdgcn_rsqf(row_ssq(ssq, u.pm * 256 + tid) * (1.0f / DM) + EPS);
    }
    __syncthreads();
    pg8::Gemm g{(const bf16_t*)(p.ws + OFF_XB), (const bf16_t*)(p.ws + OFF_WT_IN + l * SZ_WT_IN), NTOK, INC, DM};
    EpiInproj E{p.ws, (lds_cfptr)rstd_all};
    pg8::gemm_phase<EpiInproj, TileSched, true, true>((__attribute__((address_space(3))) unsigned char*)smem, g, S, E);
    if (l + 1 < DEPTH) {
        const int ntile = 64 * 17, g_ = gridDim.x, busy = ntile % g_;
        const int vb = virt_block();
        if (busy > 0 && busy < g_) {
            if (vb >= busy) { __syncthreads(); convert_weights(p, smem, l + 1, l + 2, vb - busy, g_ - busy); }
        } else {
            __syncthreads();
            convert_weights(p, smem, l + 1, l + 2, vb, g_);
        }
    }
}

#define CJI(r) (16 * ((r) >> 3) + ((r) & 7))
template <int KROWB, int VROWB, int DV, bool SW>
DEVI void attn_sub(f32x16 (&O)[DV / 32], float& m, float& lsum, const bf16x8 (&qf)[4], const char* Ksub, const char* Vsub, int ks0, int qw,
                   int qpos, int g, float slope2) {
    constexpr int NB = DV / 32;
    const int relbase = ks0 + 8 * g - qpos;
    const float basef = slope2 * (float)relbase;
    const bool need_mask = SW || (ks0 + 31 > qw);
    bf16x8 kf[4], vf[2][NB];
#pragma unroll
    for (int kk = 0; kk < 4; ++kk) kf[kk] = *(const bf16x8*)(Ksub + kk * 32);
#pragma unroll
    for (int t = 0; t < 2; ++t)
#pragma unroll
        for (int b = 0; b < NB; ++b) vf[t][b] = *(const bf16x8*)(Vsub + b * 32 * VROWB + t * 32);
    __builtin_amdgcn_sched_barrier(0);
    f32x16 S;
#pragma unroll
    for (int r = 0; r < 16; ++r) S[r] = __builtin_fmaf(slope2, (float)CJI(r), basef);
#pragma unroll
    for (int kk = 0; kk < 4; ++kk) S = __builtin_amdgcn_mfma_f32_32x32x16_bf16(kf[kk], qf[kk], S, 0, 0, 0);
    if (need_mask) {
#pragma unroll
        for (int r = 0; r < 16; ++r) {
            const int rel = relbase + CJI(r);
            bool valid = rel <= 0;
            if (SW) valid = valid && (rel > -128) && (rel + qpos >= 0);
            S[r] = valid ? S[r] : -1e30f;
        }
    }
    float mx = S[0];
#pragma unroll
    for (int r = 1; r < 16; ++r) mx = fmaxf(mx, S[r]);
    mx = max_halves(mx);
    if (__builtin_amdgcn_ballot_w64(mx > m + 20.0f) != 0ull) {
        const float mn = fmaxf(m, mx);
        const float alpha = __builtin_amdgcn_exp2f(m - mn);
        m = mn;
        lsum *= alpha;
#pragma unroll
        for (int b = 0; b < NB; ++b)
#pragma unroll
            for (int r = 0; r < 16; ++r) O[b][r] *= alpha;
    }
    float ps = 0.f;
#pragma unroll
    for (int r = 0; r < 16; ++r) { S[r] = __builtin_amdgcn_exp2f(S[r] - m); ps += S[r]; }
    lsum += ps;
    bf16x8 P[2];
#pragma unroll
    for (int t = 0; t < 2; ++t) {
        u32x4 pk = (u32x4){pk_bf16(S[8 * t + 0], S[8 * t + 1]), pk_bf16(S[8 * t + 2], S[8 * t + 3]), pk_bf16(S[8 * t + 4], S[8 * t + 5]),
                           pk_bf16(S[8 * t + 6], S[8 * t + 7])};
        P[t] = __builtin_bit_cast(bf16x8, pk);
    }
#pragma unroll
    for (int t = 0; t < 2; ++t)
#pragma unroll
        for (int b = 0; b < NB; ++b) O[b] = __builtin_amdgcn_mfma_f32_32x32x16_bf16(vf[t][b], P[t], O[b], 0, 0, 0);
}

template <int KW, int DV, bool SW>
DEVI void attn_item(const bf16_t* __restrict__ Qp, int ldq, const bf16_t* __restrict__ Kp, int ldk, const bf16_t* __restrict__ VTp,
                    bf16_t* __restrict__ Yp, int ldy, int qw, int map, int kbeg, int kend, float slope2, float sink2, float lam, char* smem) {
    constexpr int KROWB = KW * 128 + 16;
    constexpr int VROWB = 272;
    constexpr int KCH = KW * 8;
    constexpr int NB = DV / 32;
    constexpr int KN = (128 * KCH) / NTHR, VN = (DV * 16) / NTHR;
    constexpr int ASTAGE = 128 * KROWB + DV * VROWB;
    const int tid = opaque_tid(), lane = tid & 63, q = lane & 31, g = lane >> 5, wave = __builtin_amdgcn_readfirstlane(tid >> 6);
    const int qpos = qw + q;
    bf16x8 qf[4];
#pragma unroll
    for (int kk = 0; kk < 4; ++kk) qf[kk] = *(const bf16x8*)(Qp + (size_t)qpos * ldq + map * 64 + kk * 16 + g * 8);
    f32x16 O[NB];
#pragma unroll
    for (int b = 0; b < NB; ++b)
#pragma unroll
        for (int r = 0; r < 16; ++r) O[b][r] = 0.f;
    float m = SW ? sink2 : -1e30f, lsum = (SW && g == 0) ? 1.f : 0.f;
    const int pr = (q & 0x13) | ((q & 4) << 1) | ((q & 8) >> 1);
    const int kw_off = pr * KROWB + g * 16 + map * 128;
    const int vw_off = 128 * KROWB + q * VROWB + g * 16;
    u32x4 kreg[KN], vreg[VN];
#define ATT_GLOAD(KT0)                                                                         \
    {                                                                                          \
        _Pragma("unroll") for (int i = 0; i < KN; ++i) {                                       \
            const int id = tid + NTHR * i, row = id / KCH, ch = id % KCH;                      \
            int tok = (KT0) + row;                                                             \
            tok = tok < 0 ? 0 : (tok > SEQ - 1 ? SEQ - 1 : tok);                               \
            kreg[i] = *(const u32x4*)(Kp + (size_t)tok * ldk + ch * 8);                        \
        }                                                                                      \
        _Pragma("unroll") for (int i = 0; i < VN; ++i) {                                       \
            const int id = tid + NTHR * i, r = id >> 4, ch = id & 15;                          \
            int s_ = (KT0) + ch * 8;                                                           \
            s_ = s_ < 0 ? 0 : (s_ > SEQ - 8 ? SEQ - 8 : s_);                                   \
            vreg[i] = *(const u32x4*)(VTp + (size_t)r * SEQ + s_);                             \
        }                                                                                      \
    }
#define ATT_LSTORE(BUF)                                                                        \
    {                                                                                          \
        char* D_ = smem + (BUF) * ASTAGE;                                                      \
        _Pragma("unroll") for (int i = 0; i < KN; ++i) { const int id = tid + NTHR * i, row = id / KCH, ch = id % KCH; *(u32x4*)(D_ + row * KROWB + ch * 16) = kreg[i]; } \
        _Pragma("unroll") for (int i = 0; i < VN; ++i) { const int id = tid + NTHR * i, r = id >> 4, ch = id & 15; *(u32x4*)(D_ + 128 * KROWB + r * VROWB + ch * 16) = vreg[i]; } \
    }
    int kt0 = kbeg;
    if (SW) { while (kt0 + 127 < 0) kt0 += 128; }
    ATT_GLOAD(kt0)
    __syncthreads();
    ATT_LSTORE(0)
    if (kt0 + 128 < kend) ATT_GLOAD(kt0 + 128)
    __syncthreads();
    int cur = 0;
    for (; kt0 < kend; kt0 += 128) {
        const char* St = smem + cur * ASTAGE;
#pragma unroll 1
        for (int sub = 0; sub < 4; ++sub) {
            const int ks0 = kt0 + 32 * sub;
            if (ks0 > qw + 31) break;
            if (SW && (ks0 + 31 < qw - 127 || ks0 + 31 < 0)) continue;
            attn_sub<KROWB, VROWB, DV, SW>(O, m, lsum, qf, St + kw_off + sub * 32 * KROWB, St + vw_off + sub * 64, ks0, qw, qpos, g, slope2);
        }
        if (kt0 + 128 < kend) {
            ATT_LSTORE(cur ^ 1)
            if (kt0 + 256 < kend) ATT_GLOAD(kt0 + 256)
        }
        __syncthreads();
        cur ^= 1;
    }
#undef ATT_GLOAD
#undef ATT_LSTORE
    const float lt = sum_halves(lsum);
    if (!SW) {
        __syncthreads();
        char* X = smem + (wave >> 1) * 16384;
        const float sc = (map ? lam : 1.0f) / lt;
#pragma unroll
        for (int b = 0; b < NB; ++b)
#pragma unroll
            for (int r = 0; r < 16; ++r) O[b][r] *= sc;
        if (map) {
#pragma unroll
            for (int b = 0; b < NB; ++b)
#pragma unroll
                for (int j = 0; j < 4; ++j)
                    *(f32x4*)(X + ((b * 4 + j) * 64 + lane) * 16) = (f32x4){O[b][4 * j + 0], O[b][4 * j + 1], O[b][4 * j + 2], O[b][4 * j + 3]};
        }
        __syncthreads();
        if (!map) {
            float ss = 0.f;
#pragma unroll
            for (int b = 0; b < NB; ++b)
#pragma unroll
                for (int j = 0; j < 4; ++j) {
                    const f32x4 ob = *(const f32x4*)(X + ((b * 4 + j) * 64 + lane) * 16);
#pragma unroll
                    for (int i = 0; i < 4; ++i) {
                        const float a = O[b][4 * j + i] - ob[i];
                        O[b][4 * j + i] = a;
                        ss += a * a;
                    }
                }
            ss = sum_halves(ss);
            const float rn = __builtin_amdgcn_rsqf(ss * (1.0f / DV) + EPS);
#pragma unroll
            for (int b = 0; b < NB; ++b)
#pragma unroll
                for (int j = 0; j < 4; ++j) {
                    const int dv = 32 * b + 8 * j + 4 * g;
                    *(u32x2*)(Yp + (size_t)qpos * ldy + dv) = (u32x2){pk_bf16(O[b][4 * j + 0] * rn, O[b][4 * j + 1] * rn),
                                                                      pk_bf16(O[b][4 * j + 2] * rn, O[b][4 * j + 3] * rn)};
                }
        }
    } else {
        const float inv0 = 1.0f / lt;
#pragma unroll
        for (int b = 0; b < NB; ++b)
#pragma unroll
            for (int j = 0; j < 4; ++j) {
                const int dv = 32 * b + 8 * j + 4 * g;
                *(u32x2*)(Yp + (size_t)qpos * ldy + dv) = (u32x2){pk_bf16(O[b][4 * j + 0] * inv0, O[b][4 * j + 1] * inv0),
                                                                  pk_bf16(O[b][4 * j + 2] * inv0, O[b][4 * j + 3] * inv0)};
            }
    }
}

__device__ __forceinline__ void phase_attn(const Params& p, int l, float lam, float lam_init, char* smem, int* s_item) {
    const int tid = opaque_tid(), wave = __builtin_amdgcn_readfirstlane(tid >> 6);
    int* ctr = (int*)(p.ws + OFF_CTR) + l;
    const bf16_t* QKDA = (const bf16_t*)(p.ws + OFF_QKDA);
    const bf16_t* VTDA = (const bf16_t*)(p.ws + OFF_VTDA);
    const bf16_t* QSW = (const bf16_t*)(p.ws + OFF_QSW);
    const bf16_t* KSW = (const bf16_t*)(p.ws + OFF_KSW);
    const bf16_t* VTSW = (const bf16_t*)(p.ws + OFF_VTSW);
    bf16_t* Y = (bf16_t*)(p.ws + OFF_Y);
    const int xcd = blockIdx.x & 7, slot = blockIdx.x >> 3, nslots = gridDim.x >> 3;
    (void)ctr; (void)s_item;
    for (int r = 0; r < 2; ++r)
        for (int j = slot; j < 32; j += nslots) {
            const int qb = r ? 31 - j : j, bh = 2 * xcd + r, b = bh >> 2, h = bh & 3;
            const int q0 = qb * 128;
            const float slope2 = exp2f(-2.0f * (h + 1)) * LOG2E;
            __syncthreads();
            attn_item<2, 128, false>(QKDA + (size_t)b * SEQ * 1024 + h * 128, 1024, QKDA + (size_t)b * SEQ * 1024 + 512 + h * 128, 1024,
                                     VTDA + (size_t)(b * 4 + h) * 128 * SEQ, Y + (size_t)b * SEQ * 512 + h * 128, 512, q0 + 32 * (wave >> 1),
                                     wave & 1, 0, q0 + 128, slope2, 0.f, lam, smem);
        }
    for (int j = slot; j < 64; j += nslots) {
        const int b = xcd >> 1, kvh = xcd & 1;
        const int q0 = j * 64, qw = q0 + 32 * (wave >> 2), head = kvh * 4 + (wave & 3);
        const float slope2 = exp2f(-(float)(head + 1)) * LOG2E;
        const float sink2 = p.sinks[l * 8 + head] * LOG2E;
        __syncthreads();
        attn_item<1, 64, true>(QSW + (size_t)b * SEQ * 512 + head * 64, 512, KSW + (size_t)b * SEQ * 128 + kvh * 64, 128,
                               VTSW + (size_t)(b * 2 + kvh) * 64 * SEQ, Y + (size_t)NTOK * 512 + (size_t)b * SEQ * 512 + head * 64, 512, qw, 0, q0 - 128,
                               q0 + 64, slope2, sink2, 0.f, smem);
    }
}

__device__ __forceinline__ void phase_branch(const Params& p, int l, char* smem) {
    const bf16_t* Yda = (const bf16_t*)(p.ws + OFF_Y);
    const bf16_t* Ysw = Yda + (size_t)NTOK * 512;
    for (int t = virt_block(); t < 64 * 4; t += gridDim.x) {
        int mt, nt;
        tile_order(t, 64, 4, mt, nt);
        BranchSched S{mt, nt, Yda, Ysw, (const bf16_t*)(p.ws + OFF_WT_DA + l * SZ_WT_BR), (const bf16_t*)(p.ws + OFF_WT_SW + l * SZ_WT_BR)};
        pg8::Gemm g{Yda, nullptr, NTOK, DM, 512};
        EpiBranch E{p.ws};
        __syncthreads();
        pg8::gemm_phase<EpiBranch, BranchSched, true, true>((__attribute__((address_space(3))) unsigned char*)smem, g, S, E);
    }
}

__device__ __forceinline__ void phase_resid(const Params& p, const bf16_t* A, int lda, const bf16_t* WT, int K, const float* xold, float* ssq, char* smem) {
    (void)lda;
    TileSched S{64, 4, virt_block(), (int)gridDim.x};
    pg8::Gemm g{A, WT, NTOK, DM, K};
    EpiResid E{p.ws, xold, ssq};
    __syncthreads();
    pg8::gemm_phase<EpiResid, TileSched, false, true>((__attribute__((address_space(3))) unsigned char*)smem, g, S, E);
}

__device__ __forceinline__ void phase_up(const Params& p, int l, char* smem) {
    const int tid = opaque_tid();
    const float* ssq = (const float*)(p.ws + OFF_SSQ_FFN);
    pg8::Gemm g{(const bf16_t*)(p.ws + OFF_XB), (const bf16_t*)(p.ws + OFF_WT_UP + l * SZ_WT_UP), NTOK, DFF2, DM};
    int tpar = 0;
    for (int t = virt_block(); t < 68 * 22; t += gridDim.x) {
        int mt, nt;
        tile_order(t, 68, 22, mt, nt);
        const int b = mt / 17, ti = mt % 17;
        const int pos0 = -2 + 254 * ti;
        float* rstd_s = (float*)(smem + RSTD_OFF) + (tpar & 1) * 256;
        ++tpar;
        if (tid < 256) {
            int pos = pos0 + tid;
            const bool zero = pos < 0;
            pos = pos < 0 ? 0 : (pos > SEQ - 1 ? SEQ - 1 : pos);
            const float rs = __builtin_amdgcn_rsqf(row_ssq(ssq, b * SEQ + pos) * (1.0f / DM) + EPS);
            rstd_s[tid] = zero ? 0.f : rs;
        }
        __syncthreads();
        OneUnit S{{0, nt, 0}, (long)b * SEQ + pos0};
        EpiUp E{p.ws, p.conv_w + (size_t)l * 3 * DFF2, p.conv_b + (size_t)l * DFF2, (lds_cfptr)rstd_s, b, pos0, nt};
        pg8::gemm_phase<EpiUp, OneUnit, false, true>((__attribute__((address_space(3))) unsigned char*)smem, g, S, E);
    }
}

__device__ __forceinline__ void phase_final(const Params& p) {
    const int tid = opaque_tid(), lane = tid & 63, wave = tid >> 6;
    const float* ssq = (const float*)(p.ws + OFF_SSQ_MIX);
    const bf16_t* XB = (const bf16_t*)(p.ws + OFF_XB);
    for (int row = blockIdx.x * 8 + wave; row < NTOK; row += gridDim.x * 8) {
        float* xr = p.out + (size_t)row * DM;
        const float rs = __builtin_amdgcn_rsqf(row_ssq(ssq, row) * (1.0f / DM) + EPS);
#pragma unroll
        for (int i = 0; i < 4; ++i) {
            const u32x2 xv = *(const u32x2*)(XB + (size_t)row * DM + i * 256 + lane * 4);
            f32x4 w = *(const f32x4*)(p.norm_final_w + i * 256 + lane * 4);
            f32x4 v;
            v[0] = bf2f_lo(xv[0]) * rs * w[0]; v[1] = bf2f_hi(xv[0]) * rs * w[1]; v[2] = bf2f_lo(xv[1]) * rs * w[2]; v[3] = bf2f_hi(xv[1]) * rs * w[3];
            *(f32x4*)(xr + i * 256 + lane * 4) = v;
        }
    }
}

#define XB_TMO      128
#define XB_XCNT(j)  (256  + 64 * (j))
#define XB_XSUB(j)  (1280 + 64 * (j))
#define XB_XGEN(j)  (2304 + 64 * (j))
#define XB_TOP      3328
#define XB_TOPGEN   3392
#define XCD_BAR_WORDS 3456
#define XB_SPIN_CAP (1u << 22)
DEVI unsigned xb_ld(unsigned* p) { return __hip_atomic_load(p, __ATOMIC_RELAXED, __HIP_MEMORY_SCOPE_AGENT); }
DEVI unsigned xb_add(unsigned* p, unsigned v) { return __hip_atomic_fetch_add(p, v, __ATOMIC_RELAXED, __HIP_MEMORY_SCOPE_AGENT); }
DEVI unsigned xb_xcc_id() { return (unsigned)__builtin_amdgcn_s_getreg((3 << 11) | 20) & 0xFu; }
#define XB_SPIN(cond, bar) do { unsigned _sp = 0; while (cond) {   \
    if ((++_sp & 255u) == 0u) { if (xb_ld(&(bar)[XB_TMO])) break; if (_sp > XB_SPIN_CAP) { atomicAdd(&(bar)[XB_TMO], 1u); break; } } } } while (0)
DEVI void xcd_barrier_complete(unsigned* bar, unsigned x, unsigned& nloc, unsigned& nx) {
    const unsigned G = gridDim.x;
    unsigned sum, cnt, mine, sp = 0u;
    for (;;) {
        sum = 0u; cnt = 0u; mine = 0u;
#pragma unroll
        for (unsigned j = 0; j < 16; ++j) { const unsigned c = xb_ld(&bar[XB_XCNT(j)]); sum += c; cnt += (c > 0u) ? 1u : 0u; mine = (j == x) ? c : mine; }
        if (sum == G) break;
        __builtin_amdgcn_s_sleep(1);
        if ((++sp & 255u) == 0u) { if (xb_ld(&bar[XB_TMO])) break; if (sp > XB_SPIN_CAP) { atomicAdd(&bar[XB_TMO], 1u); break; } }
    }
    nloc = mine > 0u ? mine : 1u; nx = cnt > 0u ? cnt : 1u;
}
__device__ __attribute__((noinline)) void xcd_barrier(char* ws, volatile unsigned* st) {
    asm volatile("s_waitcnt vmcnt(0)" ::: "memory");
    __syncthreads();
    if (threadIdx.x == 0) {
        unsigned* bar = (unsigned*)(ws + OFF_BAR);
        const unsigned x = xb_xcc_id();
        __builtin_amdgcn_s_waitcnt(0);
        unsigned nloc = st[0], nx = st[1];
        if (nloc == 0u) { xcd_barrier_complete(bar, x, nloc, nx); st[0] = nloc; st[1] = nx; }
        const unsigned old = xb_add(&bar[XB_XSUB(x)], 1u);
        const unsigned gen = old / nloc;
        if (old + 1u == (gen + 1u) * nloc) {
            __builtin_amdgcn_fence(__ATOMIC_RELEASE, "agent");
            asm volatile("s_waitcnt vmcnt(0)" ::: "memory");
            const unsigned og = xb_add(&bar[XB_TOP], 1u);
            const unsigned tg = og / nx;
            if (og + 1u == (tg + 1u) * nx) xb_add(&bar[XB_TOPGEN], 1u);
            else XB_SPIN(xb_ld(&bar[XB_TOPGEN]) == tg, bar);
            __builtin_amdgcn_fence(__ATOMIC_ACQUIRE, "agent");
            xb_add(&bar[XB_XGEN(x)], 1u);
            asm volatile("s_waitcnt vmcnt(0)" ::: "memory");
        } else {
            XB_SPIN(xb_ld(&bar[XB_XGEN(x)]) == gen, bar);
            __builtin_amdgcn_fence(__ATOMIC_ACQUIRE, "agent");
            asm volatile("s_waitcnt vmcnt(0)" ::: "memory");
        }
    }
    __syncthreads();
}

__global__ void __launch_bounds__(NTHR) mega_kernel(Params p, int phase_lo, int phase_hi, int use_sync) {
    __shared__ __attribute__((aligned(16))) char smem[SMEM_BYTES];
    __shared__ int s_item;
    cg::grid_group grid = cg::this_grid();
    int ph = 0;
#define PHASE_BEGIN if (ph >= phase_lo && ph < phase_hi) {
    __shared__ __attribute__((aligned(16))) unsigned xb_words[4];
    if (threadIdx.x < 4) xb_words[threadIdx.x] = 0u;
    if (threadIdx.x == 0 && use_sync) (void)xb_add(&((unsigned*)(p.ws + OFF_BAR))[XB_XCNT(xb_xcc_id())], 1u);
    __syncthreads();
#define PHASE_END   if (use_sync) { if (phase_lo < 0) grid.sync(); else xcd_barrier(p.ws, xb_words); } } ++ph;
    PHASE_BEGIN phase_convert(p, smem); PHASE_END
    for (int l = 0; l < DEPTH; ++l) {
        const float lam_init = 0.8f - 0.6f * expf(-0.3f * (float)l);
        float d1 = 0.f, d2 = 0.f;
        for (int i = 0; i < 64; ++i) { d1 += p.lq1[l * 64 + i] * p.lk1[l * 64 + i]; d2 += p.lq2[l * 64 + i] * p.lk2[l * 64 + i]; }
        const float lam = expf(d1) - expf(d2) + lam_init;
        PHASE_BEGIN phase_inproj(p, l, smem); PHASE_END
        PHASE_BEGIN phase_attn(p, l, lam, lam_init, smem, &s_item); PHASE_END
        PHASE_BEGIN phase_branch(p, l, smem); PHASE_END
        PHASE_BEGIN phase_resid(p, (const bf16_t*)(p.ws + OFF_QKDA), 1024, (const bf16_t*)(p.ws + OFF_WT_MIX + l * SZ_WT_MIX), 1024,
                                l == 0 ? p.x : nullptr, (float*)(p.ws + OFF_SSQ_FFN), smem); PHASE_END
        PHASE_BEGIN phase_up(p, l, smem); PHASE_END
        PHASE_BEGIN phase_resid(p, (const bf16_t*)(p.ws + OFF_GATES), DFF, (const bf16_t*)(p.ws + OFF_WT_DN + l * SZ_WT_DN), DFF, nullptr,
                                (float*)(p.ws + OFF_SSQ_MIX), smem); PHASE_END
    }
    if (ph >= phase_lo && ph < phase_hi) phase_final(p);
}

extern "C" void kernel_launch(void* const* d_in, const int* in_sizes, int n_in, void* d_out, int out_size, void* d_ws, size_t ws_size,
                              hipStream_t stream) {
    static int grid_blocks = 0;
    if (!grid_blocks) {
        int dev = 0, cus = 0, per_cu = 0;
        hipGetDevice(&dev);
        hipDeviceGetAttribute(&cus, hipDeviceAttributeMultiprocessorCount, dev);
        hipOccupancyMaxActiveBlocksPerMultiprocessor(&per_cu, mega_kernel, NTHR, 0);
        if (per_cu > 1) per_cu = 1;
        if (per_cu < 1) per_cu = 1;
        grid_blocks = cus * per_cu;
    }
    Params p{};
    const float* const* in = (const float* const*)d_in;
    p.x = in[0]; p.norm_mix_w = in[1]; p.w_in = in[2]; p.lq1 = in[3]; p.lk1 = in[4]; p.lq2 = in[5]; p.lk2 = in[6];
    p.subln_w = in[7]; p.sinks = in[8]; p.w_br_da = in[9]; p.w_br_sw = in[10]; p.w_mix_out = in[11]; p.norm_ffn_w = in[12];
    p.w_up = in[13]; p.conv_w = in[14]; p.conv_b = in[15]; p.w_down = in[16]; p.norm_final_w = in[17];
    p.out = (float*)d_out;
    p.ws = (char*)d_ws;
    if (ws_size < WS_TOTAL) { fprintf(stderr, "workspace too small: %zu < %zu\n", ws_size, (size_t)WS_TOTAL); return; }
#ifndef MULTI_LAUNCH
#define MULTI_LAUNCH 0
#endif
#if MULTI_LAUNCH
    for (int ph = 0; ph < 2 + 6 * DEPTH; ++ph) mega_kernel<<<dim3(grid_blocks), dim3(NTHR), 0, stream>>>(p, ph, ph + 1, 0);
#else
    int lo = 0, hi = 1000, us = 1;
    void* args[] = {&p, &lo, &hi, &us};
    hipMemsetAsync((char*)d_ws + OFF_BAR, 0, XCD_BAR_WORDS * 4, stream);
    hipError_t e = hipLaunchCooperativeKernel((void*)mega_kernel, dim3(grid_blocks), dim3(NTHR), args, 0, stream);
    if (e != hipSuccess) fprintf(stderr, "cooperative launch failed: %s (grid %d)\n", hipGetErrorString(e), grid_blocks);
#endif
}
```
